# Optimizing an MI355X kernel written in HIP

```python
import jax, jax.numpy as jnp
from jax import lax
import numpy as np

D_MODEL = 1024
BATCH = 32
SEQ = 2048
DEPTH = 4

N_MIXERS = 2
N_GLA_LAYERS = (DEPTH + 1) // 2
N_SB_LAYERS = DEPTH // 2
GLA_HEADS = 4
GLA_KD = D_MODEL // 2
GLA_VD = D_MODEL
GLA_HK = GLA_KD // GLA_HEADS
GLA_HV = GLA_VD // GLA_HEADS
GLA_GATE_RANK = 16
GLA_TAU = 16.0
GLA_CHUNK = 64
GLA_IN = 2 * GLA_KD + 2 * GLA_VD + GLA_GATE_RANK
SB_HEAD_DIM = 64
SB_HEADS = D_MODEL // SB_HEAD_DIM
SB_QBLOCK = 128
D_FF = ((8 * D_MODEL // 3 + 255) // 256) * 256
NORM_EPS = 1e-6

kernel_name = 'hybrid_gla_stickbreaking_swiglu'


def _rmsnorm(x, g):
    xf = x.astype(jnp.float32)
    y = xf * lax.rsqrt(jnp.mean(xf * xf, axis=-1, keepdims=True) + NORM_EPS)
    return (y * g.astype(jnp.float32)).astype(x.dtype)


def _gla_mixer(h, w_in, w_gate2, b_gate, norm_g, w_out):
    B, S, _ = h.shape
    n_chunks = S // GLA_CHUNK
    proj = h @ w_in
    q, k, v, r, g_lr = jnp.split(proj, [GLA_KD, 2 * GLA_KD, 2 * GLA_KD + GLA_VD, 2 * GLA_KD + 2 * GLA_VD], axis=-1)
    log_a = jax.nn.log_sigmoid((g_lr @ w_gate2 + b_gate).astype(jnp.float32)) / GLA_TAU

    def to_chunks(t, d):
        return t.astype(jnp.float32).reshape(B, n_chunks, GLA_CHUNK, GLA_HEADS, d).transpose(1, 0, 3, 2, 4)

    qc = to_chunks(q, GLA_HK) * (GLA_HK ** -0.5)
    kc = to_chunks(k, GLA_HK)
    vc = to_chunks(v, GLA_HV)
    ac = to_chunks(log_a, GLA_HK)
    causal = jnp.tril(jnp.ones((GLA_CHUNK, GLA_CHUNK), dtype=bool))

    def step(state, inp):
        qb, kb, vb, ab = inp
        bcum = jnp.cumsum(ab, axis=2)
        diff = bcum[:, :, :, None, :] - bcum[:, :, None, :, :]
        decay = jnp.exp(jnp.where(causal[:, :, None], diff, -jnp.inf))
        scores = jnp.einsum('bhtk,bhsk,bhtsk->bhts', qb, kb, decay)
        o = jnp.einsum('bhts,bhsv->bhtv', scores, vb) + jnp.einsum('bhtk,bhkv->bhtv', qb * jnp.exp(bcum), state)
        blast = bcum[:, :, -1:, :]
        state = state * jnp.exp(blast[:, :, 0, :, None]) + jnp.einsum('bhsk,bhsv->bhkv', kb * jnp.exp(blast - bcum), vb)
        return state, o

    state0 = jnp.zeros((B, GLA_HEADS, GLA_HK, GLA_HV), jnp.float32)
    _, o = lax.scan(step, state0, (qc, kc, vc, ac))
    o = o.transpose(1, 0, 3, 2, 4).reshape(B, S, GLA_HEADS, GLA_HV)
    o = _rmsnorm(o, norm_g).reshape(B, S, GLA_VD)
    o = o * jax.nn.silu(r.astype(jnp.float32))
    return o.astype(h.dtype) @ w_out


def _sb_mixer(h, w_in, q_norm_g, k_norm_g, w_out):
    B, S, _ = h.shape
    q, k, v = jnp.split(h @ w_in, 3, axis=-1)
    heads = lambda t: t.reshape(B, S, SB_HEADS, SB_HEAD_DIM).transpose(0, 2, 1, 3)
    q = _rmsnorm(heads(q), q_norm_g).astype(jnp.float32)
    k = _rmsnorm(heads(k), k_norm_g).astype(jnp.float32)
    v = heads(v).astype(jnp.float32)
    scale = SB_HEAD_DIM ** -0.5
    outs = []
    for blk in range(S // SB_QBLOCK):
        t0 = blk * SB_QBLOCK
        t1 = t0 + SB_QBLOCK
        kb = k[:, :, :t1]
        vb = v[:, :, :t1]
        z = jnp.einsum('bhtd,bhsd->bhts', q[:, :, t0:t1], kb) * scale
        t_idx = t0 + jnp.arange(SB_QBLOCK)[:, None]
        s_idx = jnp.arange(t1)[None, :]
        mask = s_idx < t_idx
        log_1mb = jnp.where(mask, jax.nn.log_sigmoid(-z), 0.0)
        rem = lax.cumsum(log_1mb, axis=3, reverse=True) - log_1mb
        w = jnp.where(mask, jnp.exp(jax.nn.log_sigmoid(z) + rem), 0.0)
        outs.append(jnp.einsum('bhts,bhsd->bhtd', w, vb))
    o = jnp.concatenate(outs, axis=2).transpose(0, 2, 1, 3).reshape(B, S, D_MODEL)
    return o.astype(h.dtype) @ w_out


def _swiglu(h, w_gate_up, w_down):
    g, u = jnp.split(h @ w_gate_up, 2, axis=-1)
    return (jax.nn.silu(g) * u) @ w_down


def setup_inputs(seed: int = 0) -> dict:
    key = jax.random.key(seed)
    ks = jax.random.split(key, 16)
    nrm = lambda k, shape, fan_in: jax.random.normal(k, shape, jnp.float32) * (fan_in ** -0.5)
    gain = lambda k, shape: 1.0 + 0.02 * jax.random.normal(k, shape, jnp.float32)
    return {
        'x': jax.random.normal(ks[0], (BATCH, SEQ, D_MODEL), jnp.float32),
        'attn_norm_g': gain(ks[1], (DEPTH, D_MODEL)),
        'ffn_norm_g': gain(ks[2], (DEPTH, D_MODEL)),
        'gla_w_in': nrm(ks[3], (N_GLA_LAYERS, D_MODEL, GLA_IN), D_MODEL),
        'gla_w_gate2': nrm(ks[4], (N_GLA_LAYERS, GLA_GATE_RANK, GLA_KD), GLA_GATE_RANK),
        'gla_b_gate': 0.01 * jax.random.normal(ks[5], (N_GLA_LAYERS, GLA_KD), jnp.float32),
        'gla_norm_g': gain(ks[6], (N_GLA_LAYERS, GLA_HV)),
        'gla_w_out': nrm(ks[7], (N_GLA_LAYERS, GLA_VD, D_MODEL), GLA_VD),
        'sb_w_in': nrm(ks[8], (N_SB_LAYERS, D_MODEL, 3 * D_MODEL), D_MODEL),
        'sb_q_norm_g': gain(ks[9], (N_SB_LAYERS, SB_HEAD_DIM)),
        'sb_k_norm_g': gain(ks[10], (N_SB_LAYERS, SB_HEAD_DIM)),
        'sb_w_out': nrm(ks[11], (N_SB_LAYERS, D_MODEL, D_MODEL), D_MODEL),
        'ffn_w_gate_up': nrm(ks[12], (DEPTH, D_MODEL, 2 * D_FF), D_MODEL),
        'ffn_w_down': nrm(ks[13], (DEPTH, D_FF, D_MODEL), D_FF),
    }


def reference(x, attn_norm_g, ffn_norm_g, gla_w_in, gla_w_gate2, gla_b_gate, gla_norm_g, gla_w_out,
              sb_w_in, sb_q_norm_g, sb_k_norm_g, sb_w_out, ffn_w_gate_up, ffn_w_down):
    for i in range(DEPTH):
        h = _rmsnorm(x, attn_norm_g[i])
        j = i // N_MIXERS
        if i % N_MIXERS == 0:
            x = x + _gla_mixer(h, gla_w_in[j], gla_w_gate2[j], gla_b_gate[j], gla_norm_g[j], gla_w_out[j])
        else:
            x = x + _sb_mixer(h, sb_w_in[j], sb_q_norm_g[j], sb_k_norm_g[j], sb_w_out[j])
        h = _rmsnorm(x, ffn_norm_g[i])
        x = x + _swiglu(h, ffn_w_gate_up[i], ffn_w_down[i])
    return x
```

```cpp
#include <hip/hip_runtime.h>
#include <cstdio>
#include <cstdint>
namespace pg8 {
#define PG8_LAS __attribute__((address_space(3)))
typedef unsigned short bf16_t;
typedef short bf16x8 __attribute__((ext_vector_type(8)));
typedef float f32x4 __attribute__((ext_vector_type(4)));
typedef unsigned u32x4 __attribute__((ext_vector_type(4)));
constexpr int BM = 256, BK = 64, HALF = 128, HTB = HALF * BK * 2  , STAGE_BYTES = 8 * HTB, NXCD = 8, WGM = 8;

__host__ __device__ __forceinline__ int lds_byte(int r, int c) { const int st = (r >> 4) * 2 + (c >> 5), rr = r & 15, cc = c & 31, ob = rr * 64 + cc * 2; return st * 1024 + (ob ^ (((ob >> 9) & 1) << 5)); }
__host__ __device__ __forceinline__ void stage_rc(int b, int& R, int& C) { const int st = b / 1024, sb = b % 1024, swz = sb ^ (((sb >> 9) & 1) << 5); R = (st >> 1) * 16 + swz / 64; C = (st & 1) * 32 + (swz % 64) / 2; }
__host__ __device__ __forceinline__ int perm32(int rho) { const int n = rho >> 4, i = rho & 15; return 8 * (i >> 2) + 4 * n + (i & 3); }

struct Unit { int pm, pn; };
struct Gemm { const bf16_t* A; const bf16_t* Bt; int M, N, K; };

struct StaticOrder {
    int nM, nN, nwg, G, c;
    __host__ __device__ void init(int M, int N, int G_, int c_) { nM = M / BM; nN = N / BM; nwg = nM * nN; G = G_; c = c_; }
    __host__ __device__ bool next(int i, Unit& u) const {
        const long L = (long)i * G + c; if (L >= nwg) return false;
        int wgid = (int)L; { const int q = nwg / NXCD, r = nwg % NXCD, xcd = wgid % NXCD, off = wgid / NXCD; wgid = (xcd < r ? xcd * (q + 1) : r * (q + 1) + (xcd - r) * q) + off; }
        const int nig = WGM * nN, gid = wgid / nig, fm = gid * WGM, gsz = (nM - fm) < WGM ? (nM - fm) : WGM;
        u.pm = fm + ((wgid % nig) % gsz); u.pn = (wgid % nig) / gsz; return true;
    }
    __device__ __forceinline__ void a_ready(const Unit&) const {}
    __device__ __forceinline__ void done(const Unit&) const {}
};
__device__ __forceinline__ unsigned cvt_pk_bf16(float lo, float hi) { unsigned r; asm volatile("v_cvt_pk_bf16_f32 %0, %1, %2" : "=v"(r) : "v"(lo), "v"(hi)); return r; }
typedef float f32x2 __attribute__((ext_vector_type(2)));
constexpr float NORM_EPS = 1e-6f;
constexpr float LOG2E_F = 1.4426950408889634f;
__device__ __forceinline__ float row_rstd(const float* rowss, int row, int fq) {
    const f32x4 v = *(const f32x4*)(rowss + (size_t)row * 16 + 4 * fq);
    float s = (v[0] + v[1]) + (v[2] + v[3]);
    s += __shfl_xor(s, 16); s += __shfl_xor(s, 32);
    return __builtin_amdgcn_rsqf(s * (1.0f / 1024.0f) + NORM_EPS);
}
__device__ __forceinline__ u32x4 pack8(const f32x4& v0, const f32x4& v1) { u32x4 w; w.x = cvt_pk_bf16(v0[0], v0[1]); w.y = cvt_pk_bf16(v0[2], v0[3]); w.z = cvt_pk_bf16(v1[0], v1[1]); w.w = cvt_pk_bf16(v1[2], v1[3]); return w; }

template <int MODE> struct EpiProj {
    static constexpr bool PERM = true, AFTER_DRAIN = false;
    bf16_t* O; int ldc; const float* rowss; const float* gq; const float* gk; float qscale;
    __device__ __forceinline__ void operator()(const f32x4 (&acc)[2][2][4][2], const Unit& u, int wr, int wc, int fr, int fq) const {
        const int row0 = u.pm * BM + wr * 64 + fr;
        if constexpr (MODE == 0) {
            const int col0 = u.pn * BM + wc * 32 + 8 * fq;
#pragma unroll
            for (int ai = 0; ai < 2; ++ai)
#pragma unroll
                for (int m = 0; m < 4; ++m) { const int row = row0 + ai * HALF + m * 16; const float rs = row_rstd(rowss, row, fq); bf16_t* rowp = O + (size_t)row * ldc + col0;
#pragma unroll
                    for (int bj = 0; bj < 2; ++bj) { const f32x4 v0 = acc[ai][bj][m][0] * rs, v1 = acc[ai][bj][m][1] * rs; *(u32x4*)(rowp + bj * HALF) = pack8(v0, v1); } }
        } else {
            const int which = u.pn >> 2;
            const int col0 = u.pn * BM + wc * 64 + 8 * fq;
            f32x4 g[2][2]; float post = 1.f;
#pragma unroll
            for (int bj = 0; bj < 2; ++bj)
#pragma unroll
                for (int n = 0; n < 2; ++n) g[bj][n] = (f32x4){1.f, 1.f, 1.f, 1.f};
            if (which < 2) { const float* gp = which == 0 ? gq : gk; post = which == 0 ? qscale : 1.f;
#pragma unroll
                for (int bj = 0; bj < 2; ++bj)
#pragma unroll
                    for (int n = 0; n < 2; ++n) g[bj][n] = *(const f32x4*)(gp + 32 * bj + 8 * fq + 4 * n); }
#pragma unroll
            for (int ai = 0; ai < 2; ++ai)
#pragma unroll
                for (int m = 0; m < 4; ++m) { const int row = row0 + ai * HALF + m * 16; const float rs = row_rstd(rowss, row, fq);
                    f32x4 y[2][2]; float ss = 0.f;
#pragma unroll
                    for (int bj = 0; bj < 2; ++bj)
#pragma unroll
                        for (int n = 0; n < 2; ++n) { y[bj][n] = acc[ai][bj][m][n] * rs; const f32x4 q = y[bj][n] * y[bj][n]; ss += (q[0] + q[1]) + (q[2] + q[3]); }
                    ss += __shfl_xor(ss, 16); ss += __shfl_xor(ss, 32);
                    float r = 1.f; if (which < 2) r = __builtin_amdgcn_rsqf(ss * (1.0f / 64.0f) + NORM_EPS) * post;
#pragma unroll
                    for (int bj = 0; bj < 2; ++bj) { const f32x4 v0 = y[bj][0] * r * g[bj][0], v1 = y[bj][1] * r * g[bj][1];
                        *(u32x4*)(O + (size_t)row * ldc + col0 + 32 * bj) = pack8(v0, v1); } }
        }
    }
};
struct EpiSwiGLU {
    static constexpr bool PERM = true, AFTER_DRAIN = false;
    bf16_t* H; int ldh; const float* rowss;
    __device__ __forceinline__ void operator()(const f32x4 (&acc)[2][2][4][2], const Unit& u, int wr, int wc, int fr, int fq) const {
        const int row0 = u.pm * BM + wr * 64 + fr, col0 = u.pn * HALF + wc * 32 + 8 * fq;
#pragma unroll
        for (int ai = 0; ai < 2; ++ai)
#pragma unroll
            for (int m = 0; m < 4; ++m) { const int row = row0 + ai * HALF + m * 16; const float rs = row_rstd(rowss, row, fq); f32x4 o[2];
#pragma unroll
                for (int n = 0; n < 2; ++n) { const f32x4 gt = acc[ai][0][m][n] * rs, up = acc[ai][1][m][n] * rs;
#pragma unroll
                    for (int e = 0; e < 4; ++e) { const float s = gt[e]; const float sg = __builtin_amdgcn_rcpf(1.0f + __builtin_amdgcn_exp2f(-s * LOG2E_F)); o[n][e] = s * sg * up[e]; } }
                *(u32x4*)(H + (size_t)row * ldh + col0) = pack8(o[0], o[1]); }
    }
};
struct EpiResid {
    static constexpr bool PERM = true, AFTER_DRAIN = false;
    const float* base; float* out; bf16_t* xb; float* rowss;
    __device__ __forceinline__ void operator()(const f32x4 (&acc)[2][2][4][2], const Unit& u, int wr, int wc, int fr, int fq) const {
        const int row0 = u.pm * BM + wr * 64 + fr, col0 = u.pn * BM + wc * 32 + 8 * fq;
#pragma unroll
        for (int ai = 0; ai < 2; ++ai)
#pragma unroll
            for (int m = 0; m < 4; ++m) { const int row = row0 + ai * HALF + m * 16; const size_t off = (size_t)row * 1024 + col0; float ss = 0.f;
#pragma unroll
                for (int bj = 0; bj < 2; ++bj) { const f32x4 b0 = *(const f32x4*)(base + off + bj * HALF), b1 = *(const f32x4*)(base + off + bj * HALF + 4);
                    const f32x4 v0 = b0 + acc[ai][bj][m][0], v1 = b1 + acc[ai][bj][m][1];
                    *(f32x4*)(out + off + bj * HALF) = v0; *(f32x4*)(out + off + bj * HALF + 4) = v1; *(u32x4*)(xb + off + bj * HALF) = pack8(v0, v1);
                    const f32x4 q0 = v0 * v0, q1 = v1 * v1; ss += ((q0[0] + q0[1]) + (q0[2] + q0[3])) + ((q1[0] + q1[1]) + (q1[2] + q1[3])); }
                ss += __shfl_xor(ss, 16); ss += __shfl_xor(ss, 32);
                if (fq == 0) rowss[(size_t)row * 16 + 4 * u.pn + wc] = ss; }
    }
};
template <class Epi, class Sched, bool ALIGN_EPI = false, bool SP2 = false>
__device__ __forceinline__ void gemm_phase(PG8_LAS unsigned char* lds, const Gemm g, const Sched& S, const Epi& E) {
    int tid_ = threadIdx.x; asm volatile("" : "+v"(tid_));
    const int tid = tid_, wid = __builtin_amdgcn_readfirstlane(tid >> 6), lane = tid & 63, wr = wid >> 2, wc = wid & 3, fr = lane & 15, fq = lane >> 4;
    const int K = g.K, nt = K / BK;
    unsigned voffA[2], voffB[2];
#pragma unroll
    for (int i = 0; i < 2; ++i) { int R, C; stage_rc(tid * 16 + i * 8192, R, C); const int Rb = Epi::PERM ? ((R & ~31) + perm32(R & 31)) : R;
        voffA[i] = (unsigned)(R * K + C) * 2u; voffB[i] = (unsigned)(Rb * K + C) * 2u; }
    const size_t kstep = (size_t)(BK * 2);
    const size_t hstep = (size_t)HALF * K * 2;
    const size_t tstep = 2 * hstep;
    const unsigned ldsw = (unsigned)wid * 1024u;
    const int aoff = lds_byte(wr * 64 + fr, fq * 8), boff = lds_byte(wc * 32 + fr, fq * 8);
#define PG8_SA(b, h) (((b) * 2 + (h)) * HTB)
#define PG8_SB(b, h) ((4 + (b) * 2 + (h)) * HTB)
#define PG8_STAGE(bufoff, gbase, voff) do { _Pragma("unroll") for (int _i = 0; _i < 2; ++_i) \
        __builtin_amdgcn_global_load_lds((const unsigned*)((const char*)(gbase) + (voff)[_i]), (PG8_LAS unsigned*)(lds + (bufoff) + ldsw + _i * 8192), 16, 0, 0); } while (0)
#define PG8_LDA(dst, b, h) do { _Pragma("unroll") for (int m = 0; m < 4; ++m) _Pragma("unroll") for (int k = 0; k < 2; ++k) dst[m][k] = *(const PG8_LAS bf16x8*)(lds + PG8_SA(b, h) + aoff + m * 2048 + k * 1024); } while (0)
#define PG8_LDB(dst, b, h) do { _Pragma("unroll") for (int n = 0; n < 2; ++n) _Pragma("unroll") for (int k = 0; k < 2; ++k) dst[n][k] = *(const PG8_LAS bf16x8*)(lds + PG8_SB(b, h) + boff + n * 2048 + k * 1024); } while (0)
#define PG8_MMA(ai, bj, At, Bt) do { __builtin_amdgcn_s_setprio(1); _Pragma("unroll") for (int m = 0; m < 4; ++m) _Pragma("unroll") for (int n = 0; n < 2; ++n) _Pragma("unroll") for (int k = 0; k < 2; ++k) \
        acc[ai][bj][m][n] = __builtin_amdgcn_mfma_f32_16x16x32_bf16(Bt[n][k], At[m][k], acc[ai][bj][m][n], 0, 0, 0); __builtin_amdgcn_s_setprio(0); } while (0)
#define PG8_WAIT_V(n) asm volatile("s_waitcnt vmcnt(" #n ")" ::: "memory")
#define PG8_WAIT_L(n) asm volatile("s_waitcnt lgkmcnt(" #n ")" ::: "memory")
#define PG8_BAR __builtin_amdgcn_s_barrier()
#define PG8_SCHED __builtin_amdgcn_sched_barrier(0)
    Unit cur, nxt; int ui = 0;
    if (!S.next(0, cur)) return;
    f32x4 acc[2][2][4][2];
#pragma unroll
    for (int a = 0; a < 2; ++a)
#pragma unroll
        for (int b = 0; b < 2; ++b)
#pragma unroll
            for (int m = 0; m < 4; ++m)
#pragma unroll
                for (int n = 0; n < 2; ++n) acc[a][b][m][n] = (f32x4){0.f, 0.f, 0.f, 0.f};
    bf16x8 At[4][2], B0[2][2], B1[2][2];
    const char* cA = (const char*)g.A + (size_t)cur.pm * tstep; const char* cB = (const char*)g.Bt + (size_t)cur.pn * tstep;
    S.a_ready(cur);
    if constexpr (SP2) {
        PG8_STAGE(PG8_SB(0, 0), cB, voffB); PG8_STAGE(PG8_SB(0, 1), cB + hstep, voffB); PG8_STAGE(PG8_SA(0, 0), cA, voffA); PG8_STAGE(PG8_SA(0, 1), cA + hstep, voffA);
        if (wr == 1) PG8_BAR;
        PG8_WAIT_V(2); PG8_BAR;
        PG8_STAGE(PG8_SB(1, 0), cB + kstep, voffB); PG8_STAGE(PG8_SA(1, 0), cA + kstep, voffA); PG8_STAGE(PG8_SB(1, 1), cB + hstep + kstep, voffB);
        PG8_WAIT_V(6); PG8_BAR;
    } else {
        PG8_STAGE(PG8_SB(0, 0), cB, voffB); PG8_STAGE(PG8_SA(0, 0), cA, voffA); PG8_STAGE(PG8_SB(0, 1), cB + hstep, voffB); PG8_STAGE(PG8_SA(0, 1), cA + hstep, voffA);
        if (wr == 1) PG8_BAR;
        PG8_WAIT_V(4); PG8_BAR;
        PG8_STAGE(PG8_SB(1, 0), cB + kstep, voffB); PG8_STAGE(PG8_SA(1, 0), cA + kstep, voffA); PG8_STAGE(PG8_SB(1, 1), cB + hstep + kstep, voffB);
        PG8_WAIT_V(6); PG8_BAR;
    }
    for (;;) {
        const bool has_next = S.next(ui + 1, nxt);
        const char* nA = has_next ? (const char*)g.A + (size_t)nxt.pm * tstep : cA; const char* nB = has_next ? (const char*)g.Bt + (size_t)nxt.pn * tstep : cB;
        for (int t = 0; t < nt; t += 2) {
            const bool last = (t == nt - 2);
            const char* a1 = cA + (size_t)(t + 1) * kstep;
            const char* a2 = last ? nA : cA + (size_t)(t + 2) * kstep; const char* b2 = last ? nB : cB + (size_t)(t + 2) * kstep;
            const char* a3 = a2 + kstep; const char* b3 = b2 + kstep;
            if (last && has_next) S.a_ready(nxt);
            if constexpr (SP2) {
            PG8_LDB(B0, 0, 0); PG8_LDB(B1, 0, 1); PG8_SCHED; PG8_LDA(At, 0, 0); PG8_STAGE(PG8_SA(1, 1), a1 + hstep, voffA);
            PG8_WAIT_V(8); PG8_WAIT_L(0); PG8_BAR; PG8_MMA(0, 0, At, B0); PG8_MMA(0, 1, At, B1); PG8_BAR; PG8_SCHED;
            PG8_LDA(At, 0, 1); PG8_STAGE(PG8_SB(0, 0), b2, voffB); PG8_STAGE(PG8_SB(0, 1), b2 + hstep, voffB); PG8_STAGE(PG8_SA(0, 0), a2, voffA);
            PG8_WAIT_V(8); PG8_WAIT_L(0); PG8_BAR; PG8_MMA(1, 0, At, B0); PG8_MMA(1, 1, At, B1); PG8_BAR; PG8_SCHED;
            PG8_LDB(B0, 1, 0); PG8_LDB(B1, 1, 1); PG8_SCHED; PG8_LDA(At, 1, 0); PG8_STAGE(PG8_SA(0, 1), a2 + hstep, voffA);
            PG8_WAIT_V(8); PG8_WAIT_L(0); PG8_BAR; PG8_MMA(0, 0, At, B0); PG8_MMA(0, 1, At, B1); PG8_BAR; PG8_SCHED;
            PG8_LDA(At, 1, 1); PG8_STAGE(PG8_SB(1, 0), b3, voffB); PG8_STAGE(PG8_SB(1, 1), b3 + hstep, voffB); PG8_STAGE(PG8_SA(1, 0), a3, voffA);
            PG8_WAIT_V(8); PG8_WAIT_L(0); PG8_BAR; PG8_MMA(1, 0, At, B0); PG8_MMA(1, 1, At, B1); PG8_BAR; PG8_SCHED;
            } else {
            PG8_LDB(B0, 0, 0); PG8_SCHED; PG8_LDA(At, 0, 0); PG8_STAGE(PG8_SA(1, 1), a1 + hstep, voffA);
            PG8_WAIT_L(8); PG8_BAR; PG8_WAIT_L(0); PG8_MMA(0, 0, At, B0); PG8_BAR; PG8_SCHED;
            PG8_LDB(B1, 0, 1); PG8_STAGE(PG8_SB(0, 0), b2, voffB);
            PG8_BAR; PG8_WAIT_L(0); PG8_MMA(0, 1, At, B1); PG8_BAR;
            PG8_LDA(At, 0, 1); PG8_STAGE(PG8_SA(0, 0), a2, voffA);
            PG8_BAR; PG8_WAIT_L(0); PG8_MMA(1, 0, At, B0); PG8_BAR; PG8_SCHED;
            PG8_STAGE(PG8_SB(0, 1), b2 + hstep, voffB);
            PG8_WAIT_V(6); PG8_BAR; PG8_MMA(1, 1, At, B1); PG8_BAR;
            PG8_LDB(B0, 1, 0); PG8_SCHED; PG8_LDA(At, 1, 0); PG8_STAGE(PG8_SA(0, 1), a2 + hstep, voffA);
            PG8_WAIT_L(8); PG8_BAR; PG8_WAIT_L(0); PG8_MMA(0, 0, At, B0); PG8_BAR; PG8_SCHED;
            PG8_LDB(B1, 1, 1); PG8_STAGE(PG8_SB(1, 0), b3, voffB);
            PG8_BAR; PG8_WAIT_L(0); PG8_MMA(0, 1, At, B1); PG8_BAR;
            PG8_LDA(At, 1, 1); PG8_STAGE(PG8_SA(1, 0), a3, voffA);
            PG8_BAR; PG8_WAIT_L(0); PG8_MMA(1, 0, At, B0); PG8_BAR; PG8_SCHED;
            PG8_STAGE(PG8_SB(1, 1), b3 + hstep, voffB);
            PG8_WAIT_V(6); PG8_BAR; PG8_MMA(1, 1, At, B1); PG8_BAR;
            }
        }
        if constexpr (ALIGN_EPI) { if (wr == 0) PG8_BAR; }
        if constexpr (!Epi::AFTER_DRAIN) { E(acc, cur, wr, wc, fr, fq); S.done(cur); }
        if (!has_next) break;
#pragma unroll
        for (int a = 0; a < 2; ++a)
#pragma unroll
            for (int b = 0; b < 2; ++b)
#pragma unroll
                for (int m = 0; m < 4; ++m)
#pragma unroll
                    for (int n = 0; n < 2; ++n) acc[a][b][m][n] = (f32x4){0.f, 0.f, 0.f, 0.f};
        cur = nxt; cA = nA; cB = nB; ++ui;
        if constexpr (ALIGN_EPI) { if (wr == 1) PG8_BAR; }
    }
    PG8_WAIT_V(0);
    if constexpr (!ALIGN_EPI) { if (wr == 0) PG8_BAR; }
    PG8_BAR;
    if constexpr (Epi::AFTER_DRAIN) { E.fused(acc, cur, wr, wc, fr, fq, lds, wid, lane); S.done(cur); }
#undef PG8_SA
#undef PG8_SB
#undef PG8_STAGE
#undef PG8_LDA
#undef PG8_LDB
#undef PG8_MMA
#undef PG8_WAIT_V
#undef PG8_WAIT_L
#undef PG8_BAR
#undef PG8_SCHED
}
}
#define GAS __attribute__((address_space(1)))
#define LAS __attribute__((address_space(3)))
typedef unsigned short bf16;
typedef unsigned v4u __attribute__((ext_vector_type(4)));
typedef float f32x4 __attribute__((ext_vector_type(4)));
typedef short bf16x8 __attribute__((ext_vector_type(8)));
typedef GAS unsigned gu32;
typedef GAS unsigned long long gu64;
#define RLX_AGENT __ATOMIC_RELAXED, __HIP_MEMORY_SCOPE_AGENT
#define LDS_WAIT() asm volatile("s_waitcnt lgkmcnt(0)" ::: "memory")
#define VM_WAIT() asm volatile("s_waitcnt vmcnt(0)" ::: "memory")
__device__ __forceinline__ unsigned long long rt() { return __builtin_amdgcn_s_memrealtime(); }
__device__ __forceinline__ unsigned f2bf(float f) { unsigned u = __builtin_bit_cast(unsigned, f); return (u + 0x7fffu + ((u >> 16) & 1u)) >> 16; }
__device__ __forceinline__ unsigned pk2(float lo, float hi) { return f2bf(lo) | (f2bf(hi) << 16); }

#define XB_TMO      128
#define XB_XCNT(j)  (256  + 64 * (j))
#define XB_XSUB(j)  (1280 + 64 * (j))
#define XB_XGEN(j)  (2304 + 64 * (j))
#define XB_TOP      3328
#define XB_TOPGEN   3392
#define XCD_BAR_WORDS 3456
#define XB_SPIN_CAP (1u << 18)

__device__ __forceinline__ unsigned xb_ld(unsigned* p)              { return __hip_atomic_load(p, __ATOMIC_RELAXED, __HIP_MEMORY_SCOPE_AGENT); }
__device__ __forceinline__ unsigned xb_add(unsigned* p, unsigned v) { return __hip_atomic_fetch_add(p, v, __ATOMIC_RELAXED, __HIP_MEMORY_SCOPE_AGENT); }
__device__ __forceinline__ unsigned xb_xcc_id() { return (unsigned)__builtin_amdgcn_s_getreg((3 << 11) | 20) & 0xFu; }
#define XB_SPIN(cond, bar) do { unsigned _sp = 0; while (cond) { __builtin_amdgcn_s_sleep(1); \
    if ((++_sp & 255u) == 0u) { if (xb_ld(&(bar)[XB_TMO])) break; if (_sp > XB_SPIN_CAP) { atomicAdd(&(bar)[XB_TMO], 1u); break; } } } } while (0)

struct XcdBarrier {
    unsigned* bar; unsigned x;
    volatile LAS unsigned* st;
};

__device__ __forceinline__ XcdBarrier xcd_barrier_post(unsigned* bar, volatile LAS unsigned* st) {
    XcdBarrier b; b.bar = bar; b.x = xb_xcc_id(); b.st = st;
    if (threadIdx.x == 0) (void)xb_add(&bar[XB_XCNT(b.x)], 1u);
    return b;
}
__device__ __forceinline__ void xcd_barrier_complete(unsigned* bar, unsigned x, unsigned& nloc, unsigned& nx) {
    const unsigned G = gridDim.x * gridDim.y * gridDim.z;
    unsigned sum, cnt, mine, sp = 0u;
    for (;;) {
        sum = 0u; cnt = 0u; mine = 0u;
#pragma unroll
        for (unsigned j = 0; j < 16; ++j) { const unsigned c = xb_ld(&bar[XB_XCNT(j)]); sum += c; cnt += (c > 0u) ? 1u : 0u; mine = (j == x) ? c : mine; }
        if (sum == G) break;
        __builtin_amdgcn_s_sleep(1);
        if ((++sp & 255u) == 0u) { if (xb_ld(&bar[XB_TMO])) break; if (sp > XB_SPIN_CAP) { atomicAdd(&bar[XB_TMO], 1u); break; } }
    }
    nloc = mine > 0u ? mine : 1u; nx = cnt > 0u ? cnt : 1u;
}

__device__ __forceinline__ void xcd_barrier(const XcdBarrier& b) {
    asm volatile("s_waitcnt vmcnt(0)" ::: "memory");
    __syncthreads();
    if (threadIdx.x == 0) {
        unsigned* bar = b.bar;
        __builtin_amdgcn_s_waitcnt(0);
        unsigned nloc = b.st[0], nx = b.st[1];
        if (nloc == 0u) { xcd_barrier_complete(bar, b.x, nloc, nx); b.st[0] = nloc; b.st[1] = nx; }
        const unsigned old = xb_add(&bar[XB_XSUB(b.x)], 1u);
        const unsigned gen = old / nloc;
        if (old + 1u == (gen + 1u) * nloc) {
            __builtin_amdgcn_fence(__ATOMIC_RELEASE, "agent");
            asm volatile("s_waitcnt vmcnt(0)" ::: "memory");
            const unsigned og = xb_add(&bar[XB_TOP], 1u);
            const unsigned tg = og / nx;
            if (og + 1u == (tg + 1u) * nx) xb_add(&bar[XB_TOPGEN], 1u);
            else XB_SPIN(xb_ld(&bar[XB_TOPGEN]) == tg, bar);
            __builtin_amdgcn_fence(__ATOMIC_ACQUIRE, "agent");
            xb_add(&bar[XB_XGEN(b.x)], 1u);
            asm volatile("s_waitcnt vmcnt(0)" ::: "memory");
        } else {
            XB_SPIN(xb_ld(&bar[XB_XGEN(b.x)]) == gen, bar);
            __builtin_amdgcn_fence(__ATOMIC_ACQUIRE, "agent");
            asm volatile("s_waitcnt vmcnt(0)" ::: "memory");
        }
    }
    __syncthreads();
}

constexpr int BATCH = 32, SEQ = 2048, DM = 1024, M = BATCH * SEQ;
constexpr int GLA_H = 4, GLA_HK = 128, GLA_HV = 256, GLA_RANK = 16, GLA_CHUNK = 64, GLA_IN = 3088, GLA_NP = 3328;
constexpr int SB_N = 3072;
constexpr int DFF = 2816;
constexpr float EPS = 1e-6f, LOG2E = 1.4426950408889634f;
constexpr int NWAVES = 8;

constexpr size_t MiB = 1u << 20;
constexpr size_t WS_CTL = 0, CTL_ZERO_BYTES = 1 * MiB;
constexpr size_t WS_GLA_WIN = 2 * MiB;
constexpr size_t WS_GLA_WOUT = 16 * MiB;
constexpr size_t WS_SB_WIN = 20 * MiB;
constexpr size_t WS_SB_WOUT = 32 * MiB;
constexpr size_t WS_WGU = 36 * MiB;
constexpr size_t WS_WD = 80 * MiB;
constexpr size_t WS_ROWSS = 104 * MiB;
constexpr size_t WS_XB = 108 * MiB;
constexpr size_t WS_OG = 236 * MiB;
constexpr size_t WS_PROJ = 364 * MiB;
constexpr size_t WS_END = 780 * MiB;
constexpr int CW_BAR = 4096;

constexpr int RING_BYTES = 131072;
constexpr int LDSCTL_OFF = RING_BYTES, MISC_OFF = LDSCTL_OFF + 320;
constexpr int LDS_BYTES = 147456;

__device__ __forceinline__ float wave_sum(float v) {
#pragma unroll
    for (int o = 1; o < 64; o <<= 1) v += __shfl_xor(v, o);
    return v;
}
__device__ __forceinline__ unsigned cvtpk(float lo, float hi) { unsigned r; asm("v_cvt_pk_bf16_f32 %0, %1, %2" : "=v"(r) : "v"(lo), "v"(hi)); return r; }
__device__ __forceinline__ float bf2f(unsigned short b) { return __uint_as_float(((unsigned)b) << 16); }
__device__ __forceinline__ void glds16(const void* g, unsigned lds_base) {
    unsigned sv; asm volatile("s_mov_b32 %0, m0\n\ts_mov_b32 m0, %2\n\ts_nop 0\n\tglobal_load_lds_dwordx4 %1, off\n\ts_mov_b32 m0, %0" : "=&s"(sv) : "v"(g), "s"(lds_base) : "memory"); }
typedef short s16x4 __attribute__((ext_vector_type(4)));
typedef float f32x16 __attribute__((ext_vector_type(16)));
typedef unsigned u32x2 __attribute__((ext_vector_type(2)));
typedef LAS const char* lds_cptr;
__device__ __forceinline__ s16x4 vtr(lds_cptr p) { return __builtin_bit_cast(s16x4, __builtin_amdgcn_ds_read_tr16_b64_v4i16((LAS s16x4*)p)); }
__device__ __forceinline__ bf16x8 cat8(s16x4 a, s16x4 b) { return (bf16x8){a[0], a[1], a[2], a[3], b[0], b[1], b[2], b[3]}; }
__device__ __forceinline__ int crow(int r, int hi) { return (r & 3) + 8 * (r >> 2) + 4 * hi; }
#define MFMA32(a, b, c) __builtin_amdgcn_mfma_f32_32x32x16_bf16((a), (b), (c), 0, 0, 0)
#define WG_BAR() asm volatile("s_waitcnt vmcnt(0) lgkmcnt(0)\n\ts_barrier" ::: "memory")
__device__ __forceinline__ bf16x8 pk8(const f32x16& x, int s) {
    v4u p; p.x = cvtpk(x[8 * s], x[8 * s + 1]); p.y = cvtpk(x[8 * s + 2], x[8 * s + 3]); p.z = cvtpk(x[8 * s + 4], x[8 * s + 5]); p.w = cvtpk(x[8 * s + 6], x[8 * s + 7]);
    return __builtin_bit_cast(bf16x8, p); }

__device__ __forceinline__ void wt_item(const float* W, int ldw, int c0, int nvalid, const float* g, bf16* WT, int K, int n0, int k0, LAS float* scr, int lane) {
    const int n = lane & 31;
#pragma unroll 8
    for (int i = 0; i < 32; ++i) { const int kk = 2 * i + (lane >> 5); float v = 0.f; if (n < nvalid) v = W[(size_t)(k0 + kk) * ldw + c0 + n]; if (g) v *= g[k0 + kk]; scr[kk * 33 + n] = v; }
    LDS_WAIT(); asm volatile("" ::: "memory");
    const int c = lane & 7;
#pragma unroll
    for (int j = 0; j < 4; ++j) { const int nn = (lane >> 3) + 8 * j; const LAS float* s = scr + (8 * c) * 33 + nn;
        v4u o; o.x = pk2(s[0 * 33], s[1 * 33]); o.y = pk2(s[2 * 33], s[3 * 33]); o.z = pk2(s[4 * 33], s[5 * 33]); o.w = pk2(s[6 * 33], s[7 * 33]);
        *(v4u*)(WT + (size_t)(n0 + nn) * K + k0 + 8 * c) = o; }
    LDS_WAIT(); asm volatile("" ::: "memory");
}
struct Ptrs {
    const float *x, *attn_g, *ffn_g, *gla_win, *gla_w2, *gla_b, *gla_ng, *gla_wout, *sb_win, *sb_qg, *sb_kg, *sb_wout, *wgu, *wd;
    float* out; unsigned char* ws;
};
__device__ __forceinline__ void p0_prologue(const Ptrs& P, LAS unsigned char* lds, int vcu, int G, int wave, int lane) {
    LAS float* scr = (LAS float*)(lds + wave * 16384);
    const int gw = vcu * NWAVES + wave, NGW = G * NWAVES;
    constexpr int I_GW = 16 * (GLA_NP / 32), I_O = 16 * 32, I_SW = 16 * (SB_N / 32), I_GU = 16 * (2 * DFF / 32), I_D = (DFF / 64) * 32;
    constexpr int NITEMS = 2 * I_GW + 2 * I_O + 2 * I_SW + 2 * I_O + 4 * I_GU + 4 * I_D;
    for (int it = gw; it < NITEMS; it += NGW) {
        int r = it;
        if (r < 2 * I_GW) { const int j = r / I_GW; r -= j * I_GW; const int nblk = GLA_NP / 32, kb = r / nblk, nb = r % nblk, n0 = 32 * nb; int nv = GLA_IN - n0; nv = nv < 0 ? 0 : (nv > 32 ? 32 : nv);
            wt_item(P.gla_win + (size_t)j * DM * GLA_IN, GLA_IN, n0, nv, P.attn_g + (2 * j) * DM, (bf16*)(P.ws + WS_GLA_WIN + (size_t)j * 7 * MiB), DM, n0, 64 * kb, scr, lane); continue; } r -= 2 * I_GW;
        if (r < 2 * I_O) { const int j = r / I_O; r -= j * I_O; const int kb = r / 32, nb = r % 32;
            wt_item(P.gla_wout + (size_t)j * DM * DM, DM, 32 * nb, 32, nullptr, (bf16*)(P.ws + WS_GLA_WOUT + (size_t)j * 2 * MiB), DM, 32 * nb, 64 * kb, scr, lane); continue; } r -= 2 * I_O;
        if (r < 2 * I_SW) { const int j = r / I_SW; r -= j * I_SW; const int nblk = SB_N / 32, kb = r / nblk, nb = r % nblk, n0 = 32 * nb;
            const int pn = n0 >> 8, p = n0 & 255, bj = p >> 7, wc = (p & 127) >> 5, c0 = 256 * pn + 64 * wc + 32 * bj;
            wt_item(P.sb_win + (size_t)j * DM * SB_N, SB_N, c0, 32, P.attn_g + (2 * j + 1) * DM, (bf16*)(P.ws + WS_SB_WIN + (size_t)j * 6 * MiB), DM, n0, 64 * kb, scr, lane); continue; } r -= 2 * I_SW;
        if (r < 2 * I_O) { const int j = r / I_O; r -= j * I_O; const int kb = r / 32, nb = r % 32;
            wt_item(P.sb_wout + (size_t)j * DM * DM, DM, 32 * nb, 32, nullptr, (bf16*)(P.ws + WS_SB_WOUT + (size_t)j * 2 * MiB), DM, 32 * nb, 64 * kb, scr, lane); continue; } r -= 2 * I_O;
        if (r < 4 * I_GU) { const int i = r / I_GU; r -= i * I_GU; const int nblk = 2 * DFF / 32, kb = r / nblk, nb = r % nblk, n0 = 32 * nb;
            const int pn = n0 >> 8, p = n0 & 255, bj = p >> 7, y = p & 127, c0 = bj * DFF + 128 * pn + y;
            wt_item(P.wgu + (size_t)i * DM * 2 * DFF, 2 * DFF, c0, 32, P.ffn_g + i * DM, (bf16*)(P.ws + WS_WGU + (size_t)i * 11 * MiB), DM, n0, 64 * kb, scr, lane); continue; } r -= 4 * I_GU;
        { const int i = r / I_D; r -= i * I_D; const int kb = r / 32, nb = r % 32;
            wt_item(P.wd + (size_t)i * DFF * DM, DM, 32 * nb, 32, nullptr, (bf16*)(P.ws + WS_WD + (size_t)i * 6 * MiB), DFF, 32 * nb, 64 * kb, scr, lane); }
    }
    bf16* xb = (bf16*)(P.ws + WS_XB); float* rowss = (float*)(P.ws + WS_ROWSS);
    for (int m = gw; m < M; m += NGW) {
        const f32x4* xr = (const f32x4*)(P.x + (size_t)m * DM) + lane; f32x4 v[4]; float s = 0.f;
#pragma unroll
        for (int j = 0; j < 4; ++j) { v[j] = xr[64 * j]; s += (v[j][0] * v[j][0] + v[j][1] * v[j][1]) + (v[j][2] * v[j][2] + v[j][3] * v[j][3]); }
        s = wave_sum(s);
        u32x2* o8 = (u32x2*)(xb + (size_t)m * DM) + lane;
#pragma unroll
        for (int j = 0; j < 4; ++j) { u32x2 w; w.x = cvtpk(v[j][0], v[j][1]); w.y = cvtpk(v[j][2], v[j][3]); o8[64 * j] = w; }
        if (lane < 16) rowss[(size_t)m * 16 + lane] = lane == 0 ? s : 0.f;
    }
}

namespace sbp {
constexpr int SLOTB = 8192, LDS_K = 0, LDS_V = 2 * SLOTB, LDS_OST = 4 * SLOTB, LDS_FLAG = LDS_OST + 8 * 4096, LDS_END = LDS_FLAG + 64;
template <bool EARLY>
__device__ __forceinline__ void sb_unit(int b, int h, int qb, const bf16* QKV, bf16* O, LAS unsigned char* lds) {
    int tid_ = threadIdx.x; asm volatile("" : "+v"(tid_));
    const int tid = tid_, lane = tid & 63, r32 = lane & 31, hi = lane >> 5; const int wid = __builtin_amdgcn_readfirstlane(tid >> 6);
    const long rowbase = (long)b * SEQ; const int q0 = qb * 256, NT = 4 * qb + 4;
    const bf16* Qw = QKV + (rowbase + q0 + wid * 32) * SB_N + h * 64;
    const bf16* Kb = QKV + rowbase * SB_N + 1024 + h * 64; const bf16* Vb = Kb + 1024;
    const unsigned lds0 = (unsigned)(uintptr_t)lds;
    const bf16* ksrc = Kb + (long)lane * SB_N + wid * 8;
    const bf16* vsrc = Vb + (long)(16 * (wid & 3) + (lane >> 2)) * SB_N + (wid >> 2) * 32 + (lane & 3) * 8;
    const unsigned kdst = lds0 + LDS_K + wid * 1024, vdst = lds0 + LDS_V + wid * 1024;
#define SB_DMA(j, slot) do { glds16(ksrc + (long)(j) * 64 * SB_N, (unsigned)__builtin_amdgcn_readfirstlane(kdst + (slot) * SLOTB)); \
                             glds16(vsrc + (long)(j) * 64 * SB_N, (unsigned)__builtin_amdgcn_readfirstlane(vdst + (slot) * SLOTB)); } while (0)
    LAS unsigned* flags = (LAS unsigned*)(lds + LDS_FLAG);
    if (EARLY && lane == 0) flags[wid] = 0u;
    SB_DMA(NT - 1, 0);
    bf16x8 qr[4];
#pragma unroll
    for (int d0 = 0; d0 < 4; ++d0) qr[d0] = *(const bf16x8*)(Qw + (long)r32 * SB_N + d0 * 16 + hi * 8);
    f32x16 o0, o1;
#pragma unroll
    for (int r = 0; r < 16; ++r) { o0[r] = 0.f; o1[r] = 0.f; }
    float prun = 1.f;
    const int qw0 = q0 + wid * 32, tq = qw0 + r32;
    bool wdone = false;
    for (int t = 0; t < NT; ++t) {
        const int j = NT - 1 - t, slot = t & 1;
        WG_BAR();
        if (EARLY) { const v4u f0 = *(LAS v4u*)(flags + 8 * slot), f1 = *(LAS v4u*)(flags + 8 * slot + 4);
            if ((f0.x & f0.y & f0.z & f0.w & f1.x & f1.y & f1.z & f1.w) != 0u) break; }
        if (t + 1 < NT) SB_DMA(j - 1, slot ^ 1);
        const int k0 = 64 * j;
        if (!wdone && k0 <= qw0 + 30) {
            lds_cptr kp = (lds_cptr)lds + LDS_K + slot * SLOTB + hi * 1024 + r32 * 16;
            f32x16 p0, p1;
#pragma unroll
            for (int r = 0; r < 16; ++r) { p0[r] = 0.f; p1[r] = 0.f; }
#pragma unroll
            for (int d0 = 0; d0 < 4; ++d0) { const bf16x8 ka = *(LAS const bf16x8*)(kp + d0 * 2048), kb = *(LAS const bf16x8*)(kp + d0 * 2048 + 512);
                p0 = MFMA32(ka, qr[d0], p0); p1 = MFMA32(kb, qr[d0], p1); }
            const bool diag = (k0 + 63 >= qw0);
#pragma unroll
            for (int r = 0; r < 16; ++r) {
                float fa = __builtin_amdgcn_rcpf(1.0f + __builtin_amdgcn_exp2f(p0[r])), fb = __builtin_amdgcn_rcpf(1.0f + __builtin_amdgcn_exp2f(p1[r]));
                if (diag) { const int key = k0 + crow(r, hi); if (key >= tq) fa = 1.f; if (key + 32 >= tq) fb = 1.f; }
                p0[r] = fa; p1[r] = fb; }
            float gp[8], pt[8], pp[8];
#pragma unroll
            for (int g = 0; g < 4; ++g) { gp[g] = (p0[4 * g] * p0[4 * g + 1]) * (p0[4 * g + 2] * p0[4 * g + 3]); gp[4 + g] = (p1[4 * g] * p1[4 * g + 1]) * (p1[4 * g + 2] * p1[4 * g + 3]); }
#pragma unroll
            for (int g = 0; g < 8; ++g) { auto rr = __builtin_amdgcn_permlane32_swap(__float_as_uint(gp[g]), __float_as_uint(gp[g]), false, false);
                const float a = __uint_as_float(rr[0]), c = __uint_as_float(rr[1]); pp[g] = a * c; pt[g] = hi ? 1.0f : c; }
            float Y = prun, X[8];
#pragma unroll
            for (int g = 7; g >= 0; --g) { X[g] = Y * pt[g]; Y = Y * pp[g]; }
            prun = Y;
#pragma unroll
            for (int g = 0; g < 4; ++g) {
                float E = X[g];
#pragma unroll
                for (int i = 3; i >= 0; --i) { const float tt = E * p0[4 * g + i]; p0[4 * g + i] = E - tt; E = tt; }
                E = X[4 + g];
#pragma unroll
                for (int i = 3; i >= 0; --i) { const float tt = E * p1[4 * g + i]; p1[4 * g + i] = E - tt; E = tt; }
            }
            if (EARLY) wdone = __all(prun == 0.0f) != 0;
            const bf16x8 pw0 = pk8(p0, 0), pw1 = pk8(p0, 1), pw2 = pk8(p1, 0), pw3 = pk8(p1, 1);
            lds_cptr vp = (lds_cptr)lds + LDS_V + slot * SLOTB + ((lane >> 4) & 1) * 32 + (lane & 3) * 8 + (4 * hi + ((lane & 15) >> 2)) * 64;
#define SB_VF(dh, s) cat8(vtr(vp + (dh) * 4096 + (s) * 1024), vtr(vp + (dh) * 4096 + (s) * 1024 + 512))
            o0 = MFMA32(pw0, SB_VF(0, 0), o0); o1 = MFMA32(pw0, SB_VF(1, 0), o1);
            o0 = MFMA32(pw1, SB_VF(0, 1), o0); o1 = MFMA32(pw1, SB_VF(1, 1), o1);
            o0 = MFMA32(pw2, SB_VF(0, 2), o0); o1 = MFMA32(pw2, SB_VF(1, 2), o1);
            o0 = MFMA32(pw3, SB_VF(0, 3), o0); o1 = MFMA32(pw3, SB_VF(1, 3), o1);
#undef SB_VF
        }
        if (EARLY && lane == 0) flags[8 * (slot ^ 1) + wid] = wdone ? 1u : 0u;
    }
    bf16* Ow = O + (rowbase + q0 + wid * 32) * DM + h * 64; LAS bf16* stg = (LAS bf16*)(lds + LDS_OST) + wid * 2048;
#pragma unroll
    for (int r = 0; r < 16; ++r) { const int orow = crow(r, hi); stg[orow * 64 + r32] = (bf16)f2bf(o0[r]); stg[orow * 64 + 32 + r32] = (bf16)f2bf(o1[r]); }
    LDS_WAIT();
#pragma unroll
    for (int i = 0; i < 4; ++i) { const int row = i * 8 + (lane >> 3), ch = lane & 7; *(v4u*)(Ow + (long)row * DM + ch * 8) = *(LAS const v4u*)(stg + row * 64 + ch * 8); }
    WG_BAR();
#undef SB_DMA
}
}

namespace glp {
constexpr int PQ = 272, PT = 144;
constexpr int L_QI = 0, L_KI = L_QI + 64 * PQ, L_KT = L_KI + 64 * PQ, L_VI = 53248, L_GL = L_VI + 32768, L_TOT = L_GL + 4096, L_DEC = L_TOT + 2048, L_SS = L_DEC + 512, L_W2 = L_SS + 4096, L_BG = L_W2 + 8192, L_END = L_BG + 512;
constexpr int L_QR = L_QI, L_KR = L_KI;
static_assert(L_KT + 128 * PT <= L_VI && L_END <= RING_BYTES && 64 * 256 <= 64 * PQ, "GLA LDS map");
__device__ __forceinline__ int permk(int k) { const int x = k & 15; return (k & ~15) | (x & 3) | (((x >> 3) & 1) << 2) | (((x >> 2) & 1) << 3); }
__device__ __forceinline__ void gla_seq(int b, int h, const bf16* proj, const float* w2, const float* bg, const float* gnorm, bf16* og, LAS unsigned char* lds) {
    const int wid = __builtin_amdgcn_readfirstlane(threadIdx.x >> 6);
    const unsigned lds0 = (unsigned)(uintptr_t)lds;
    { int tid = threadIdx.x; asm volatile("" : "+v"(tid));
      for (int i = tid; i < 16 * 128; i += NWAVES * 64) ((LAS float*)(lds + L_W2))[i] = w2[(i >> 7) * 512 + h * 128 + (i & 127)];
      if (tid < 128) ((LAS float*)(lds + L_BG))[tid] = bg[h * 128 + tid]; }
    f32x16 S[4];
#pragma unroll
    for (int kt = 0; kt < 4; ++kt)
#pragma unroll
        for (int r = 0; r < 16; ++r) S[kt][r] = 0.f;
    const float qscale = 0.08838834764831845f;
    for (int c = 0; c < SEQ / GLA_CHUNK; ++c) {
        int lane = threadIdx.x & 63; asm volatile("" : "+v"(lane));
        const int r32 = lane & 31, hi = lane >> 5, tid = wid * 64 + lane, kk = tid & 127, tg = wid >> 1;
        const long tok0 = (long)b * SEQ + c * GLA_CHUNK;
        WG_BAR();
#pragma unroll
        for (int tb = 0; tb < 4; ++tb)
            glds16(proj + (tok0 + 16 * tb + (lane >> 2)) * GLA_NP + 1024 + h * 256 + 32 * wid + 8 * (lane & 3), (unsigned)__builtin_amdgcn_readfirstlane(lds0 + L_VI + wid * 4096 + tb * 1024));
#pragma unroll
        for (int i = 0; i < 2; ++i) { const long trow = tok0 + 8 * wid + 4 * i + (lane >> 4); const bf16* src = proj + trow * GLA_NP + h * 128 + 8 * (lane & 15);
            glds16(src, (unsigned)__builtin_amdgcn_readfirstlane(lds0 + L_QR + (8 * wid + 4 * i) * 256));
            glds16(src + 512, (unsigned)__builtin_amdgcn_readfirstlane(lds0 + L_KR + (8 * wid + 4 * i) * 256)); }
        if (tid < 128) { const int t = tid >> 1, half = tid & 1; const v4u g8 = *(const v4u*)(proj + (tok0 + t) * GLA_NP + 3072 + 8 * half);
            LAS f32x4* d = (LAS f32x4*)(lds + L_GL + t * 64 + half * 32);
            d[0] = (f32x4){__uint_as_float(g8.x << 16), __uint_as_float(g8.x & 0xffff0000u), __uint_as_float(g8.y << 16), __uint_as_float(g8.y & 0xffff0000u)};
            d[1] = (f32x4){__uint_as_float(g8.z << 16), __uint_as_float(g8.z & 0xffff0000u), __uint_as_float(g8.w << 16), __uint_as_float(g8.w & 0xffff0000u)}; }
        WG_BAR();
        float qv[16], kv[16];
#pragma unroll
        for (int i = 0; i < 16; ++i) { qv[i] = bf2f(*(LAS const bf16*)(lds + L_QR + (16 * tg + i) * 256 + kk * 2)); kv[i] = bf2f(*(LAS const bf16*)(lds + L_KR + (16 * tg + i) * 256 + kk * 2)); }
        float la[16];
        { const float bk = ((LAS const float*)(lds + L_BG))[kk];
#pragma unroll
          for (int i = 0; i < 16; ++i) la[i] = bk;
#pragma unroll
          for (int j4 = 0; j4 < 4; ++j4) { const LAS float* wp = (const LAS float*)(lds + L_W2) + (4 * j4) * 128 + kk; const float w0 = wp[0], w1 = wp[128], w2_ = wp[256], w3 = wp[384];
#pragma unroll
              for (int i = 0; i < 16; ++i) { const f32x4 gv = *(const LAS f32x4*)(lds + L_GL + (16 * tg + i) * 64 + j4 * 16); la[i] += (gv[0] * w0 + gv[1] * w1) + (gv[2] * w2_ + gv[3] * w3); } }
          float run = 0.f;
#pragma unroll
          for (int i = 0; i < 16; ++i) { const float z = la[i]; const float ls = fminf(z, 0.f) - __logf(1.0f + __expf(-fabsf(z)));
              run += ls * (1.0f / 16.0f); la[i] = run; }
          ((LAS float*)(lds + L_TOT))[tg * 128 + kk] = run; }
        WG_BAR();
        float off = 0.f, blast = 0.f;
#pragma unroll
        for (int g = 0; g < 4; ++g) { const float tv = ((LAS const float*)(lds + L_TOT))[g * 128 + kk]; blast += tv; if (g < tg) off += tv; }
        { const int pk_ = permk(kk); unsigned khp[8];
#pragma unroll
          for (int i = 0; i < 16; i += 2) {
            float qa, ka, kha, qb2, kb2, khb;
            { const float bc = off + la[i]; qa = qv[i] * qscale * __expf(bc); ka = kv[i] * __expf(-bc); kha = kv[i] * __expf(blast - bc); }
            { const float bc = off + la[i + 1]; qb2 = qv[i + 1] * qscale * __expf(bc); kb2 = kv[i + 1] * __expf(-bc); khb = kv[i + 1] * __expf(blast - bc); }
            const int t = 16 * tg + i;
            *(LAS bf16*)(lds + L_QI + t * PQ + pk_ * 2) = (bf16)f2bf(qa); *(LAS bf16*)(lds + L_QI + (t + 1) * PQ + pk_ * 2) = (bf16)f2bf(qb2);
            *(LAS bf16*)(lds + L_KI + t * PQ + pk_ * 2) = (bf16)f2bf(ka); *(LAS bf16*)(lds + L_KI + (t + 1) * PQ + pk_ * 2) = (bf16)f2bf(kb2);
            khp[i >> 1] = cvtpk(kha, khb); }
          LAS v4u* kd = (LAS v4u*)(lds + L_KT + kk * PT + tg * 32); kd[0] = (v4u){khp[0], khp[1], khp[2], khp[3]}; kd[1] = (v4u){khp[4], khp[5], khp[6], khp[7]}; }
        if (tg == 0) ((LAS float*)(lds + L_DEC))[kk] = __expf(blast);
        WG_BAR();
        f32x16 X00, X01, X11, OT0, OT1;
#pragma unroll
        for (int r = 0; r < 16; ++r) { X00[r] = 0.f; X01[r] = 0.f; X11[r] = 0.f; OT0[r] = 0.f; OT1[r] = 0.f; }
        lds_cptr qi = (lds_cptr)lds + L_QI + r32 * PQ + hi * 16, ki = (lds_cptr)lds + L_KI + r32 * PQ + hi * 16;
#pragma unroll
        for (int ks = 0; ks < 8; ++ks) {
            const bf16x8 a0 = *(LAS const bf16x8*)(ki + ks * 32), a1 = *(LAS const bf16x8*)(ki + 32 * PQ + ks * 32);
            const bf16x8 b0 = *(LAS const bf16x8*)(qi + ks * 32), b1 = *(LAS const bf16x8*)(qi + 32 * PQ + ks * 32);
            X00 = MFMA32(a0, b0, X00); X01 = MFMA32(a0, b1, X01); X11 = MFMA32(a1, b1, X11); }
#pragma unroll
        for (int r = 0; r < 16; ++r) if (crow(r, hi) > r32) { X00[r] = 0.f; X11[r] = 0.f; }
        lds_cptr vw = (lds_cptr)lds + L_VI + wid * 4096 + ((lane >> 4) & 1) * 32 + (lane & 3) * 8 + ((lane & 15) >> 2) * 64;
#define GL_VA(st, sp) cat8(vtr(vw + (32 * (st) + 16 * (sp) + 4 * hi) * 64), vtr(vw + (32 * (st) + 16 * (sp) + 4 * hi + 8) * 64))
        { const bf16x8 va00 = GL_VA(0, 0), va01 = GL_VA(0, 1), va10 = GL_VA(1, 0), va11 = GL_VA(1, 1);
          OT0 = MFMA32(va00, pk8(X00, 0), OT0); OT0 = MFMA32(va01, pk8(X00, 1), OT0);
          OT1 = MFMA32(va00, pk8(X01, 0), OT1); OT1 = MFMA32(va01, pk8(X01, 1), OT1);
          OT1 = MFMA32(va10, pk8(X11, 0), OT1); OT1 = MFMA32(va11, pk8(X11, 1), OT1); }
#undef GL_VA
#pragma unroll
        for (int kt = 0; kt < 4; ++kt)
#pragma unroll
            for (int sp = 0; sp < 2; ++sp) { const bf16x8 sa = pk8(S[kt], sp);
                const bf16x8 bq0 = *(LAS const bf16x8*)(qi + (2 * kt + sp) * 32), bq1 = *(LAS const bf16x8*)(qi + 32 * PQ + (2 * kt + sp) * 32);
                OT0 = MFMA32(sa, bq0, OT0); OT1 = MFMA32(sa, bq1, OT1); }
#pragma unroll
        for (int kt = 0; kt < 4; ++kt)
#pragma unroll
            for (int g = 0; g < 4; ++g) { const f32x4 d4 = *(LAS const f32x4*)(lds + L_DEC + (32 * kt + 8 * g + 4 * hi) * 4);
                S[kt][4 * g] *= d4[0]; S[kt][4 * g + 1] *= d4[1]; S[kt][4 * g + 2] *= d4[2]; S[kt][4 * g + 3] *= d4[3]; }
        lds_cptr ktp = (lds_cptr)lds + L_KT + r32 * PT + hi * 16;
#pragma unroll
        for (int ts = 0; ts < 4; ++ts) { const bf16x8 vb = cat8(vtr(vw + (16 * ts + 8 * hi) * 64), vtr(vw + (16 * ts + 8 * hi + 4) * 64));
#pragma unroll
            for (int kt = 0; kt < 4; ++kt) { const bf16x8 ak = *(LAS const bf16x8*)(ktp + kt * 32 * PT + ts * 32); S[kt] = MFMA32(ak, vb, S[kt]); } }
        float ss0 = 0.f, ss1 = 0.f;
#pragma unroll
        for (int r = 0; r < 16; ++r) { ss0 += OT0[r] * OT0[r]; ss1 += OT1[r] * OT1[r]; }
        LAS float* ssb = (LAS float*)(lds + L_SS);
        ssb[(wid * 2 + hi) * 64 + r32] = ss0; ssb[(wid * 2 + hi) * 64 + 32 + r32] = ss1;
        WG_BAR();
        float t0 = 0.f, t1 = 0.f;
#pragma unroll
        for (int i = 0; i < 16; ++i) { t0 += ssb[i * 64 + r32]; t1 += ssb[i * 64 + 32 + r32]; }
        const float rs0 = __builtin_amdgcn_rsqf(t0 * (1.0f / 256.0f) + EPS), rs1 = __builtin_amdgcn_rsqf(t1 * (1.0f / 256.0f) + EPS);
#pragma unroll
        for (int g = 0; g < 4; ++g) { const int v0 = 32 * wid + 8 * g + 4 * hi; const f32x4 gn = *(const f32x4*)(gnorm + v0);
#pragma unroll
            for (int tt = 0; tt < 2; ++tt) { const long tok = tok0 + 32 * tt + r32; const float rs = tt ? rs1 : rs0;
                const u32x2 rr = *(const u32x2*)(proj + tok * GLA_NP + 2048 + h * 256 + v0);
                const float r0 = __uint_as_float(rr.x << 16), r1 = __uint_as_float(rr.x & 0xffff0000u), r2 = __uint_as_float(rr.y << 16), r3 = __uint_as_float(rr.y & 0xffff0000u);
                const float o_0 = tt ? OT1[4 * g] : OT0[4 * g], o_1 = tt ? OT1[4 * g + 1] : OT0[4 * g + 1], o_2 = tt ? OT1[4 * g + 2] : OT0[4 * g + 2], o_3 = tt ? OT1[4 * g + 3] : OT0[4 * g + 3];
                const float y0 = o_0 * rs * gn[0] * (r0 * __builtin_amdgcn_rcpf(1.0f + __expf(-r0))), y1 = o_1 * rs * gn[1] * (r1 * __builtin_amdgcn_rcpf(1.0f + __expf(-r1)));
                const float y2 = o_2 * rs * gn[2] * (r2 * __builtin_amdgcn_rcpf(1.0f + __expf(-r2))), y3 = o_3 * rs * gn[3] * (r3 * __builtin_amdgcn_rcpf(1.0f + __expf(-r3)));
                u32x2 w; w.x = cvtpk(y0, y1); w.y = cvtpk(y2, y3);
                *(u32x2*)(og + tok * DM + h * 256 + v0) = w; } }
    }
    WG_BAR();
}
}

#ifndef SB_EARLY
#define SB_EARLY 0
#endif
struct Args { const float* in[14]; float* out; unsigned char* ws; int ph_lo, ph_hi; };
constexpr int N_PHASES = 21;
typedef __attribute__((address_space(4))) const Args* kargs_t;
__device__ __forceinline__ kargs_t kargs() { kargs_t p = (kargs_t)__builtin_amdgcn_kernarg_segment_ptr(); asm volatile("" : "+s"(p)); return p; }
__global__ void __launch_bounds__(NWAVES * 64, 2) fwd(Args args_unused) {
    extern __shared__ __attribute__((aligned(16))) unsigned char lds_raw[];
    LAS unsigned char* lds = (LAS unsigned char*)lds_raw;
    (void)args_unused;
    { const int tid = threadIdx.x; for (int u = tid; u < (LDS_BYTES - LDSCTL_OFF) / 4; u += NWAVES * 64) ((LAS unsigned*)(lds + LDSCTL_OFF))[u] = 0u; }
    __syncthreads();
    const int lo = kargs()->ph_lo, hi_ = kargs()->ph_hi;
    XcdBarrier bar; bar.bar = (unsigned*)(kargs()->ws + WS_CTL) + CW_BAR; bar.x = 0; bar.st = nullptr;
    if (hi_ - lo > 1) bar = xcd_barrier_post((unsigned*)(kargs()->ws + WS_CTL) + CW_BAR, (volatile LAS unsigned*)(lds + MISC_OFF) + 8);
#ifndef PHASE_MASK
#define PHASE_MASK 0x7ff
#endif
#define IN(k) (lo <= (k) && (k) < hi_)
#define INL(n) (((PHASE_MASK >> ((n) + 1)) & 1) && IN(pb + (n)))
#define SEAM(k) do { if (IN(k) && IN((k) + 1)) xcd_barrier(bar); } while (0)
#define WSP(T, off) ((T*)(A->ws + (off)))
#define GRID_ID const int G = gridDim.x, bx = blockIdx.x

    if ((PHASE_MASK & 1) && IN(0)) { const kargs_t A = kargs(); GRID_ID;
        const int tid = threadIdx.x, lane = tid & 63, wave = __builtin_amdgcn_readfirstlane(tid >> 6), vcu = (G % 8 == 0) ? (bx % 8) * (G / 8) + bx / 8 : bx;
        Ptrs P;
        P.x = A->in[0]; P.attn_g = A->in[1]; P.ffn_g = A->in[2]; P.gla_win = A->in[3]; P.gla_w2 = A->in[4]; P.gla_b = A->in[5]; P.gla_ng = A->in[6]; P.gla_wout = A->in[7];
        P.sb_win = A->in[8]; P.sb_qg = A->in[9]; P.sb_kg = A->in[10]; P.sb_wout = A->in[11]; P.wgu = A->in[12]; P.wd = A->in[13]; P.out = A->out; P.ws = A->ws;
        p0_prologue(P, lds, vcu, G, wave, lane); }
    SEAM(0);
#pragma unroll 1
    for (int jj = 0; jj < 2; ++jj) {
        const int pb = 1 + 10 * jj;
        if (INL(0)) { const kargs_t A = kargs(); GRID_ID;
            pg8::Gemm g{WSP(const bf16, WS_XB), WSP(const bf16, WS_GLA_WIN + (size_t)jj * 7 * MiB), M, GLA_NP, DM}; pg8::StaticOrder S; S.init(M, GLA_NP, G, bx);
            pg8::EpiProj<0> E{WSP(bf16, WS_PROJ), GLA_NP, WSP(const float, WS_ROWSS), nullptr, nullptr, 1.f};
            pg8::gemm_phase<pg8::EpiProj<0>, pg8::StaticOrder, true, true>(lds, g, S, E);
        }
        SEAM(pb + 0);
        if (INL(1)) { const kargs_t A = kargs(); GRID_ID; (void)G;
            if (bx < BATCH * GLA_H) glp::gla_seq(bx >> 2, bx & 3, WSP(const bf16, WS_PROJ), A->in[4] + (size_t)jj * GLA_RANK * 512, A->in[5] + jj * 512, A->in[6] + jj * GLA_HV, WSP(bf16, WS_OG), lds);
        }
        SEAM(pb + 1);
        if (INL(2)) { const kargs_t A = kargs(); GRID_ID;
            pg8::Gemm g{WSP(const bf16, WS_OG), WSP(const bf16, WS_GLA_WOUT + (size_t)jj * 2 * MiB), M, DM, DM}; pg8::StaticOrder S; S.init(M, DM, G, bx);
            pg8::EpiResid E{jj == 0 ? A->in[0] : (const float*)A->out, A->out, WSP(bf16, WS_XB), WSP(float, WS_ROWSS)};
            pg8::gemm_phase<pg8::EpiResid, pg8::StaticOrder, true, true>(lds, g, S, E);
        }
        SEAM(pb + 2);
        if (INL(3)) { const kargs_t A = kargs(); GRID_ID;
            pg8::Gemm g{WSP(const bf16, WS_XB), WSP(const bf16, WS_WGU + (size_t)(2 * jj) * 11 * MiB), M, 2 * DFF, DM}; pg8::StaticOrder S; S.init(M, 2 * DFF, G, bx);
            pg8::EpiSwiGLU E{WSP(bf16, WS_PROJ), DFF, WSP(const float, WS_ROWSS)};
            pg8::gemm_phase<pg8::EpiSwiGLU, pg8::StaticOrder, true, true>(lds, g, S, E);
        }
        SEAM(pb + 3);
        if (INL(4)) { const kargs_t A = kargs(); GRID_ID;
            pg8::Gemm g{WSP(const bf16, WS_PROJ), WSP(const bf16, WS_WD + (size_t)(2 * jj) * 6 * MiB), M, DM, DFF}; pg8::StaticOrder S; S.init(M, DM, G, bx);
            pg8::EpiResid E{A->out, A->out, WSP(bf16, WS_XB), WSP(float, WS_ROWSS)};
            pg8::gemm_phase<pg8::EpiResid, pg8::StaticOrder, true, true>(lds, g, S, E);
        }
        SEAM(pb + 4);
        if (INL(5)) { const kargs_t A = kargs(); GRID_ID;
            pg8::Gemm g{WSP(const bf16, WS_XB), WSP(const bf16, WS_SB_WIN + (size_t)jj * 6 * MiB), M, SB_N, DM}; pg8::StaticOrder S; S.init(M, SB_N, G, bx);
            pg8::EpiProj<1> E{WSP(bf16, WS_PROJ), SB_N, WSP(const float, WS_ROWSS), A->in[9] + jj * 64, A->in[10] + jj * 64, 0.125f * LOG2E};
            pg8::gemm_phase<pg8::EpiProj<1>, pg8::StaticOrder, true, true>(lds, g, S, E);
        }
        SEAM(pb + 5);
        if (INL(6)) { const kargs_t A = kargs(); GRID_ID;
            for (int it = bx; it < BATCH * 16 * 4; it += G) { const int bh = it >> 2, pr = it & 3;
                sbp::sb_unit<SB_EARLY != 0>(bh >> 4, bh & 15, pr, WSP(const bf16, WS_PROJ), WSP(bf16, WS_OG), lds);
                sbp::sb_unit<SB_EARLY != 0>(bh >> 4, bh & 15, 7 - pr, WSP(const bf16, WS_PROJ), WSP(bf16, WS_OG), lds); }
        }
        SEAM(pb + 6);
        if (INL(7)) { const kargs_t A = kargs(); GRID_ID;
            pg8::Gemm g{WSP(const bf16, WS_OG), WSP(const bf16, WS_SB_WOUT + (size_t)jj * 2 * MiB), M, DM, DM}; pg8::StaticOrder S; S.init(M, DM, G, bx);
            pg8::EpiResid E{A->out, A->out, WSP(bf16, WS_XB), WSP(float, WS_ROWSS)};
            pg8::gemm_phase<pg8::EpiResid, pg8::StaticOrder, true, true>(lds, g, S, E);
        }
        SEAM(pb + 7);
        if (INL(8)) { const kargs_t A = kargs(); GRID_ID;
            pg8::Gemm g{WSP(const bf16, WS_XB), WSP(const bf16, WS_WGU + (size_t)(2 * jj + 1) * 11 * MiB), M, 2 * DFF, DM}; pg8::StaticOrder S; S.init(M, 2 * DFF, G, bx);
            pg8::EpiSwiGLU E{WSP(bf16, WS_PROJ), DFF, WSP(const float, WS_ROWSS)};
            pg8::gemm_phase<pg8::EpiSwiGLU, pg8::StaticOrder, true, true>(lds, g, S, E);
        }
        SEAM(pb + 8);
        if (INL(9)) { const kargs_t A = kargs(); GRID_ID;
            pg8::Gemm g{WSP(const bf16, WS_PROJ), WSP(const bf16, WS_WD + (size_t)(2 * jj + 1) * 6 * MiB), M, DM, DFF}; pg8::StaticOrder S; S.init(M, DM, G, bx);
            pg8::EpiResid E{A->out, A->out, WSP(bf16, WS_XB), WSP(float, WS_ROWSS)};
            pg8::gemm_phase<pg8::EpiResid, pg8::StaticOrder, true, true>(lds, g, S, E);
        }
        SEAM(pb + 9);
    }
#undef IN
#undef INL
#undef SEAM
#undef WSP
#undef GRID_ID
}

#ifndef MK_PER_PHASE
#define MK_PER_PHASE 0
#endif
extern "C" void kernel_launch(void* const* d_in, const int* in_sizes, int n_in, void* d_out, int out_size, void* d_ws, size_t ws_size, hipStream_t stream) {
    static int grid = 0;
    if (grid == 0) {
        if (n_in != 14 || in_sizes[0] != M * DM || out_size != M * DM || ws_size < WS_END) { fprintf(stderr, "kernel_launch: unexpected shapes (n_in %d, in0 %d, out %d, ws %zu)\n", n_in, n_in > 0 ? in_sizes[0] : -1, out_size, ws_size); grid = -1; return; }
        int dev = 0, cus = 0, per_cu = 0;
        if (hipGetDevice(&dev) != hipSuccess || hipDeviceGetAttribute(&cus, hipDeviceAttributeMultiprocessorCount, dev) != hipSuccess) { grid = -1; return; }
        if (hipFuncSetAttribute((const void*)fwd, hipFuncAttributeMaxDynamicSharedMemorySize, LDS_BYTES) != hipSuccess) { fprintf(stderr, "kernel_launch: hipFuncSetAttribute failed\n"); grid = -1; return; }
        if (hipOccupancyMaxActiveBlocksPerMultiprocessor(&per_cu, (const void*)fwd, NWAVES * 64, LDS_BYTES) != hipSuccess || per_cu < 1) { fprintf(stderr, "kernel_launch: occupancy query says %d blocks per CU\n", per_cu); }
        (void)hipGetLastError();
        grid = cus;
    }
    if (grid < 0) return;
    (void)hipMemsetAsync((char*)d_ws + WS_CTL, 0, CTL_ZERO_BYTES, stream);
    Args a{};
    for (int i = 0; i < 14; ++i) a.in[i] = (const float*)d_in[i];
    a.out = (float*)d_out; a.ws = (unsigned char*)d_ws;
#if MK_PER_PHASE
    for (int p = 0; p < N_PHASES; ++p) { a.ph_lo = p; a.ph_hi = p + 1; hipLaunchKernelGGL(fwd, dim3(grid), dim3(NWAVES * 64), LDS_BYTES, stream, a); }
#else
    a.ph_lo = 0; a.ph_hi = N_PHASES;
    hipLaunchKernelGGL(fwd, dim3(grid), dim3(NWAVES * 64), LDS_BYTES, stream, a);
#endif
}
```

```cpp
#include <hip/hip_runtime.h>
#include <cstdio>
#include <cstdint>
namespace pg8 {
#define PG8_LAS __attribute__((address_space(3)))
typedef unsigned short bf16_t;
typedef short bf16x8 __attribute__((ext_vector_type(8)));
typedef float f32x4 __attribute__((ext_vector_type(4)));
typedef unsigned u32x4 __attribute__((ext_vector_type(4)));
constexpr int BM = 256, BK = 64, HALF = 128, HTB = HALF * BK * 2  , STAGE_BYTES = 8 * HTB, NXCD = 8, WGM = 4;

__host__ __device__ __forceinline__ int lds_byte(int r, int c) { const int st = (r >> 4) * 2 + (c >> 5), rr = r & 15, cc = c & 31, ob = rr * 64 + cc * 2; return st * 1024 + (ob ^ (((ob >> 9) & 1) << 5)); }
__host__ __device__ __forceinline__ void stage_rc(int b, int& R, int& C) { const int st = b / 1024, sb = b % 1024, swz = sb ^ (((sb >> 9) & 1) << 5); R = (st >> 1) * 16 + swz / 64; C = (st & 1) * 32 + (swz % 64) / 2; }
__host__ __device__ __forceinline__ int perm32(int rho) { const int n = rho >> 4, i = rho & 15; return 8 * (i >> 2) + 4 * n + (i & 3); }

struct Unit { int pm, pn; };
struct Gemm { const bf16_t* A; const bf16_t* Bt; int M, N, K; };

struct StaticOrder {
    int nM, nN, nwg, G, c, rev;
    __host__ __device__ void init(int M, int N, int G_, int c_, int rev_ = 0) { nM = M / BM; nN = N / BM; nwg = nM * nN; G = G_; c = c_; rev = rev_; }
    __host__ __device__ bool next(int i, Unit& u) const {
        const long L = (long)i * G + c; if (L >= nwg) return false;
        int wgid = (int)L; { const int q = nwg / NXCD, r = nwg % NXCD, xcd = wgid % NXCD, off = wgid / NXCD; wgid = (xcd < r ? xcd * (q + 1) : r * (q + 1) + (xcd - r) * q) + off; }
        const int nig = WGM * nN, gid = wgid / nig, fm = gid * WGM, gsz = (nM - fm) < WGM ? (nM - fm) : WGM;
        u.pm = fm + ((wgid % nig) % gsz); u.pn = (wgid % nig) / gsz; if (rev) u.pm = nM - 1 - u.pm; return true;
    }
    __device__ __forceinline__ void a_ready(const Unit&) const {}
    __device__ __forceinline__ void done(const Unit&) const {}
    static constexpr bool DYNAMIC = false;
    __device__ __forceinline__ unsigned request(int) const { return 0u; }
    __device__ __forceinline__ void resolve(unsigned, int) const {}
    __device__ __forceinline__ bool fetch(Unit&) const { return false; }
    __host__ __device__ void unit_of(int wgid, Unit& u) const { const int nig = WGM * nN, gid = wgid / nig, fm = gid * WGM, gsz = (nM - fm) < WGM ? (nM - fm) : WGM; u.pm = fm + ((wgid % nig) % gsz); u.pn = (wgid % nig) / gsz; if (rev) u.pm = nM - 1 - u.pm; }
};
struct PanelOrder : StaticOrder {
    int p;
    __device__ __forceinline__ bool next(int i, Unit& u) const { int q = p; asm volatile("" : "+s"(q)); u.pm = q; u.pn = i; return i < nN; }
};
struct DynOrder : StaticOrder {
    static constexpr bool DYNAMIC = true;
    unsigned* cnt; PG8_LAS int* slot;
    __device__ __forceinline__ int csize(int x) const { return nwg / NXCD + (x < nwg % NXCD ? 1 : 0); }
    __device__ __forceinline__ int cstart(int x) const { const int q = nwg / NXCD, r = nwg % NXCD; return x < r ? x * (q + 1) : r * (q + 1) + (x - r) * q; }
    __device__ __forceinline__ unsigned request(int tid) const { unsigned tok = 0u; if (tid == 0) tok = __hip_atomic_fetch_add(cnt + 64 * (c & 7), 1u, __ATOMIC_RELAXED, __HIP_MEMORY_SCOPE_AGENT); return tok; }
    __device__ __forceinline__ void resolve(unsigned tok, int tid) const {
        if (tid == 0) { const int x0 = c & 7, per = (G + 7) >> 3; int found = 0, wg = 0;
            { const int off = per + (int)tok; if (off < csize(x0)) { found = 1; wg = cstart(x0) + off; } }
            for (int k = 1; k < NXCD && !found; ++k) { const int y = (x0 + k) & 7; const int off = per + (int)__hip_atomic_fetch_add(cnt + 64 * y, 1u, __ATOMIC_RELAXED, __HIP_MEMORY_SCOPE_AGENT);
                if (off < csize(y)) { found = 1; wg = cstart(y) + off; } }
            Unit u; u.pm = 0; u.pn = 0; if (found) unit_of(wg, u);
            slot[0] = found; slot[1] = u.pm; slot[2] = u.pn; }
    }
    __device__ __forceinline__ bool fetch(Unit& u) const { const int f = __builtin_amdgcn_readfirstlane(slot[0]); u.pm = __builtin_amdgcn_readfirstlane(slot[1]); u.pn = __builtin_amdgcn_readfirstlane(slot[2]); return f != 0; }
};
__device__ __forceinline__ unsigned cvt_pk_bf16(float lo, float hi) { unsigned r; asm volatile("v_cvt_pk_bf16_f32 %0, %1, %2" : "=v"(r) : "v"(lo), "v"(hi)); return r; }
typedef float f32x2 __attribute__((ext_vector_type(2)));
constexpr float NORM_EPS = 1e-6f;
constexpr float LOG2E_F = 1.4426950408889634f;
__device__ __forceinline__ float row_rstd(const float* rowss, int row, int fq) {
    const f32x4 v = *(const f32x4*)(rowss + (size_t)row * 16 + 4 * fq);
    float s = (v[0] + v[1]) + (v[2] + v[3]);
    s += __shfl_xor(s, 16); s += __shfl_xor(s, 32);
    return __builtin_amdgcn_rsqf(s * (1.0f / 1024.0f) + NORM_EPS);
}
constexpr int RSTD_OFF = STAGE_BYTES + 1024, RSP_OFF = STAGE_BYTES + 2048;
__device__ __forceinline__ void rstd_issue_(const float* rowss, const Unit& u, int wid, int lane, PG8_LAS unsigned char* lds) {
#pragma unroll
    for (int i = 0; i < 2; ++i) { const int rowl = 16 * (2 * wid + i) + (lane >> 2);
        __builtin_amdgcn_global_load_lds((const unsigned*)(rowss + (size_t)(u.pm * BM + rowl) * 16 + 4 * (lane & 3)), (PG8_LAS unsigned*)(lds + RSP_OFF + (2 * wid + i) * 1024), 16, 0, 0); } }
__device__ __forceinline__ void rstd_consume_(int tid, PG8_LAS unsigned char* lds) {
    if (tid < BM) { const PG8_LAS f32x4* p = (const PG8_LAS f32x4*)(lds + RSP_OFF + tid * 64); const f32x4 a = p[0], b = p[1], c = p[2], d = p[3];
        const float s = (((a[0] + a[1]) + (a[2] + a[3])) + ((b[0] + b[1]) + (b[2] + b[3]))) + (((c[0] + c[1]) + (c[2] + c[3])) + ((d[0] + d[1]) + (d[2] + d[3])));
        ((PG8_LAS float*)(lds + RSTD_OFF))[tid] = __builtin_amdgcn_rsqf(s * (1.0f / 1024.0f) + NORM_EPS); }
    asm volatile("s_waitcnt lgkmcnt(0)" ::: "memory"); }
__device__ __forceinline__ u32x4 pack8(const f32x4& v0, const f32x4& v1) { u32x4 w; w.x = cvt_pk_bf16(v0[0], v0[1]); w.y = cvt_pk_bf16(v0[2], v0[3]); w.z = cvt_pk_bf16(v1[0], v1[1]); w.w = cvt_pk_bf16(v1[2], v1[3]); return w; }

template <int MODE> struct EpiProj {
    static constexpr bool PERM = true, AFTER_DRAIN = false;
    static constexpr bool RSTD = true; PG8_LAS float* rl;
    __device__ __forceinline__ void rstd_issue(const Unit& u, int wid, int lane, PG8_LAS unsigned char* lds) const { rstd_issue_(rowss, u, wid, lane, lds); }
    __device__ __forceinline__ void rstd_consume(int tid, PG8_LAS unsigned char* lds) const { rstd_consume_(tid, lds); }
    bf16_t* O; int ldc; const float* rowss; const float* gq; const float* gk; float qscale; int ncols;
    __device__ __forceinline__ void operator()(const f32x4 (&acc)[2][2][4][2], const Unit& u, int wr, int wc, int fr, int fq) const {
        const int row0 = u.pm * BM + wr * 64 + fr;
        if constexpr (MODE == 0) {
            const int col0 = u.pn * BM + wc * 32 + 8 * fq;
#pragma unroll
            for (int ai = 0; ai < 2; ++ai)
#pragma unroll
                for (int m = 0; m < 4; ++m) { const int row = row0 + ai * HALF + m * 16; const float rs = rl[wr * 64 + fr + ai * HALF + m * 16]; bf16_t* rowp = O + (size_t)row * ldc + col0;
#pragma unroll
                    for (int bj = 0; bj < 2; ++bj) { const f32x4 v0 = acc[ai][bj][m][0] * rs, v1 = acc[ai][bj][m][1] * rs; if (col0 + bj * HALF < ncols) *(u32x4*)(rowp + bj * HALF) = pack8(v0, v1); } }
        } else {
            const int which = u.pn >> 2;
            const int col0 = u.pn * BM + wc * 64 + 8 * fq;
            f32x4 g[2][2]; float post = 1.f;
#pragma unroll
            for (int bj = 0; bj < 2; ++bj)
#pragma unroll
                for (int n = 0; n < 2; ++n) g[bj][n] = (f32x4){1.f, 1.f, 1.f, 1.f};
            if (which < 2) { const float* gp = which == 0 ? gq : gk; post = which == 0 ? qscale : 1.f;
#pragma unroll
                for (int bj = 0; bj < 2; ++bj)
#pragma unroll
                    for (int n = 0; n < 2; ++n) g[bj][n] = *(const f32x4*)(gp + 32 * bj + 8 * fq + 4 * n); }
#pragma unroll
            for (int ai = 0; ai < 2; ++ai)
#pragma unroll
                for (int m = 0; m < 4; ++m) { const int row = row0 + ai * HALF + m * 16; const float rs = rl[wr * 64 + fr + ai * HALF + m * 16];
                    f32x4 y[2][2]; float ss = 0.f;
#pragma unroll
                    for (int bj = 0; bj < 2; ++bj)
#pragma unroll
                        for (int n = 0; n < 2; ++n) { y[bj][n] = acc[ai][bj][m][n] * rs; const f32x4 q = y[bj][n] * y[bj][n]; ss += (q[0] + q[1]) + (q[2] + q[3]); }
                    ss += __shfl_xor(ss, 16); ss += __shfl_xor(ss, 32);
                    float r = 1.f; if (which < 2) r = __builtin_amdgcn_rsqf(ss * (1.0f / 64.0f) + NORM_EPS) * post;
#pragma unroll
                    for (int bj = 0; bj < 2; ++bj) { const f32x4 v0 = y[bj][0] * r * g[bj][0], v1 = y[bj][1] * r * g[bj][1];
                        *(u32x4*)(O + (size_t)row * ldc + col0 + 32 * bj) = pack8(v0, v1); } }
        }
    }
};
struct EpiSwiGLU {
    static constexpr bool PERM = true, AFTER_DRAIN = false;
    bf16_t* H; int ldh; const float* rowss; PG8_LAS float* rl;
    static constexpr bool RSTD = true;
    __device__ __forceinline__ void rstd_issue(const Unit& u, int wid, int lane, PG8_LAS unsigned char* lds) const { rstd_issue_(rowss, u, wid, lane, lds); }
    __device__ __forceinline__ void rstd_consume(int tid, PG8_LAS unsigned char* lds) const { rstd_consume_(tid, lds); }
    __device__ __forceinline__ void operator()(const f32x4 (&acc)[2][2][4][2], const Unit& u, int wr, int wc, int fr, int fq) const {
        const int row0 = u.pm * BM + wr * 64 + fr, col0 = u.pn * HALF + wc * 32 + 8 * fq;
#pragma unroll
        for (int ai = 0; ai < 2; ++ai)
#pragma unroll
            for (int m = 0; m < 4; ++m) { const int row = row0 + ai * HALF + m * 16; const float rs = rl[wr * 64 + fr + ai * HALF + m * 16]; const float c1 = -rs * LOG2E_F, rs2 = rs * rs;
                const f32x4 t0 = acc[ai][0][m][0] * c1, t1 = acc[ai][0][m][1] * c1;
                f32x4 e0, e1;
                e0[0] = __builtin_amdgcn_exp2f(t0[0]); e0[1] = __builtin_amdgcn_exp2f(t0[1]); e0[2] = __builtin_amdgcn_exp2f(t0[2]); e0[3] = __builtin_amdgcn_exp2f(t0[3]);
                e1[0] = __builtin_amdgcn_exp2f(t1[0]); e1[1] = __builtin_amdgcn_exp2f(t1[1]); e1[2] = __builtin_amdgcn_exp2f(t1[2]); e1[3] = __builtin_amdgcn_exp2f(t1[3]);
                const f32x4 p0 = acc[ai][0][m][0] * acc[ai][1][m][0] * rs2, p1 = acc[ai][0][m][1] * acc[ai][1][m][1] * rs2;
                e0 = e0 + 1.0f; e1 = e1 + 1.0f;
                f32x4 r0, r1;
                r0[0] = __builtin_amdgcn_rcpf(e0[0]); r0[1] = __builtin_amdgcn_rcpf(e0[1]); r0[2] = __builtin_amdgcn_rcpf(e0[2]); r0[3] = __builtin_amdgcn_rcpf(e0[3]);
                r1[0] = __builtin_amdgcn_rcpf(e1[0]); r1[1] = __builtin_amdgcn_rcpf(e1[1]); r1[2] = __builtin_amdgcn_rcpf(e1[2]); r1[3] = __builtin_amdgcn_rcpf(e1[3]);
                *(u32x4*)(H + (size_t)row * ldh + col0) = pack8(p0 * r0, p1 * r1); }
    }
};
__device__ __forceinline__ f32x4 bf4lo(unsigned a, unsigned b) { return (f32x4){__uint_as_float(a << 16), __uint_as_float(a & 0xffff0000u), __uint_as_float(b << 16), __uint_as_float(b & 0xffff0000u)}; }
template <bool FINAL> struct EpiResid {
    static constexpr bool PERM = true, AFTER_DRAIN = false, RSTD = false;
    bf16_t* xb; float* out; float* rowss;
    __device__ __forceinline__ void operator()(const f32x4 (&acc)[2][2][4][2], const Unit& u, int wr, int wc, int fr, int fq) const {
        const int row0 = u.pm * BM + wr * 64 + fr, col0 = u.pn * BM + wc * 32 + 8 * fq;
#pragma unroll
        for (int ai = 0; ai < 2; ++ai) {
            u32x4 bv[4][2];
#pragma unroll
            for (int m = 0; m < 4; ++m)
#pragma unroll
                for (int bj = 0; bj < 2; ++bj) bv[m][bj] = *(const u32x4*)(xb + (size_t)(row0 + ai * HALF + m * 16) * 1024 + col0 + bj * HALF);
            asm volatile("" ::: "memory");
#pragma unroll
            for (int m = 0; m < 4; ++m) { const int row = row0 + ai * HALF + m * 16; const size_t off = (size_t)row * 1024 + col0; float ss = 0.f;
#pragma unroll
                for (int bj = 0; bj < 2; ++bj) { const u32x4 b = bv[m][bj];
                    const f32x4 v0 = bf4lo(b.x, b.y) + acc[ai][bj][m][0], v1 = bf4lo(b.z, b.w) + acc[ai][bj][m][1];
                    if constexpr (FINAL) { *(f32x4*)(out + off + bj * HALF) = v0; *(f32x4*)(out + off + bj * HALF + 4) = v1; }
                    else { *(u32x4*)(xb + off + bj * HALF) = pack8(v0, v1);
                        const f32x4 q0 = v0 * v0, q1 = v1 * v1; ss += ((q0[0] + q0[1]) + (q0[2] + q0[3])) + ((q1[0] + q1[1]) + (q1[2] + q1[3])); } }
                if constexpr (!FINAL) { ss += __shfl_xor(ss, 16); ss += __shfl_xor(ss, 32); if (fq == 0) rowss[(size_t)row * 16 + 4 * u.pn + wc] = ss; } }
            asm volatile("" ::: "memory");
        }
    }
};
template <class Epi, class Sched, bool ALIGN_EPI = false, bool SP2 = false>
__device__ __forceinline__ void gemm_phase(PG8_LAS unsigned char* lds, const Gemm g, const Sched& S, const Epi& E) {
    int tid_ = threadIdx.x; asm volatile("" : "+v"(tid_));
    const int tid = tid_, wid = __builtin_amdgcn_readfirstlane(tid >> 6), lane = tid & 63, wr = wid >> 2, wc = wid & 3, fr = lane & 15, fq = lane >> 4;
    const int K = g.K, nt = K / BK;
    unsigned voffA[2], voffB[2];
#pragma unroll
    for (int i = 0; i < 2; ++i) { int R, C; stage_rc(tid * 16 + i * 8192, R, C); const int Rb = Epi::PERM ? ((R & ~31) + perm32(R & 31)) : R;
        voffA[i] = (unsigned)(R * K + C) * 2u; voffB[i] = (unsigned)(Rb * K + C) * 2u; }
    const size_t kstep = (size_t)(BK * 2);
    const size_t hstep = (size_t)HALF * K * 2;
    const size_t tstep = 2 * hstep;
    const unsigned ldsw = (unsigned)wid * 1024u;
    const int aoff = lds_byte(wr * 64 + fr, fq * 8), boff = lds_byte(wc * 32 + fr, fq * 8);
#define PG8_SA(b, h) (((b) * 2 + (h)) * HTB)
#define PG8_SB(b, h) ((4 + (b) * 2 + (h)) * HTB)
#define PG8_STAGE(bufoff, gbase, voff) do { _Pragma("unroll") for (int _i = 0; _i < 2; ++_i) \
        __builtin_amdgcn_global_load_lds((const unsigned*)((const char*)(gbase) + (voff)[_i]), (PG8_LAS unsigned*)(lds + (bufoff) + ldsw + _i * 8192), 16, 0, 0); } while (0)
#define PG8_LDA(dst, b, h) do { _Pragma("unroll") for (int m = 0; m < 4; ++m) _Pragma("unroll") for (int k = 0; k < 2; ++k) dst[m][k] = *(const PG8_LAS bf16x8*)(lds + PG8_SA(b, h) + aoff + m * 2048 + k * 1024); } while (0)
#define PG8_LDB(dst, b, h) do { _Pragma("unroll") for (int n = 0; n < 2; ++n) _Pragma("unroll") for (int k = 0; k < 2; ++k) dst[n][k] = *(const PG8_LAS bf16x8*)(lds + PG8_SB(b, h) + boff + n * 2048 + k * 1024); } while (0)
#define PG8_MMA(ai, bj, At, Bt) do { __builtin_amdgcn_s_setprio(1); _Pragma("unroll") for (int m = 0; m < 4; ++m) _Pragma("unroll") for (int n = 0; n < 2; ++n) _Pragma("unroll") for (int k = 0; k < 2; ++k) \
        acc[ai][bj][m][n] = __builtin_amdgcn_mfma_f32_16x16x32_bf16(Bt[n][k], At[m][k], acc[ai][bj][m][n], 0, 0, 0); __builtin_amdgcn_s_setprio(0); } while (0)
#define PG8_WAIT_V(n) asm volatile("s_waitcnt vmcnt(" #n ")" ::: "memory")
#define PG8_WAIT_L(n) asm volatile("s_waitcnt lgkmcnt(" #n ")" ::: "memory")
#define PG8_BAR __builtin_amdgcn_s_barrier()
#define PG8_SCHED __builtin_amdgcn_sched_barrier(0)
    Unit cur, nxt; int ui = 0;
    if (!S.next(0, cur)) return;
    f32x4 acc[2][2][4][2];
#pragma unroll
    for (int a = 0; a < 2; ++a)
#pragma unroll
        for (int b = 0; b < 2; ++b)
#pragma unroll
            for (int m = 0; m < 4; ++m)
#pragma unroll
                for (int n = 0; n < 2; ++n) acc[a][b][m][n] = (f32x4){0.f, 0.f, 0.f, 0.f};
    bf16x8 At[4][2], B0[2][2], B1[2][2];
    const char* cA = (const char*)g.A + (size_t)cur.pm * tstep; const char* cB = (const char*)g.Bt + (size_t)cur.pn * tstep;
    S.a_ready(cur);
    if constexpr (SP2) {
        PG8_STAGE(PG8_SB(0, 0), cB, voffB); PG8_STAGE(PG8_SB(0, 1), cB + hstep, voffB); PG8_STAGE(PG8_SA(0, 0), cA, voffA); PG8_STAGE(PG8_SA(0, 1), cA + hstep, voffA);
        if (wr == 1) PG8_BAR;
        PG8_WAIT_V(2); PG8_BAR;
        PG8_STAGE(PG8_SB(1, 0), cB + kstep, voffB); PG8_STAGE(PG8_SA(1, 0), cA + kstep, voffA); PG8_STAGE(PG8_SB(1, 1), cB + hstep + kstep, voffB);
        PG8_WAIT_V(6); PG8_BAR;
    } else {
        PG8_STAGE(PG8_SB(0, 0), cB, voffB); PG8_STAGE(PG8_SA(0, 0), cA, voffA); PG8_STAGE(PG8_SB(0, 1), cB + hstep, voffB); PG8_STAGE(PG8_SA(0, 1), cA + hstep, voffA);
        if (wr == 1) PG8_BAR;
        PG8_WAIT_V(4); PG8_BAR;
        PG8_STAGE(PG8_SB(1, 0), cB + kstep, voffB); PG8_STAGE(PG8_SA(1, 0), cA + kstep, voffA); PG8_STAGE(PG8_SB(1, 1), cB + hstep + kstep, voffB);
        PG8_WAIT_V(6); PG8_BAR;
    }
    for (;;) {
        const unsigned tok = S.request(tid);
        bool has_next = false; const char* nA = cA; const char* nB = cB;
        if constexpr (!Sched::DYNAMIC) { has_next = S.next(ui + 1, nxt);
            nA = has_next ? (const char*)g.A + (size_t)nxt.pm * tstep : cA; nB = has_next ? (const char*)g.Bt + (size_t)nxt.pn * tstep : cB; }
        for (int t = 0; t < nt; t += 2) {
            const bool last = (t == nt - 2);
            if constexpr (Epi::RSTD) { if (last) E.rstd_issue(cur, wid, lane, lds); }
            if constexpr (Sched::DYNAMIC) { if (t == nt - 4) S.resolve(tok, tid);
                if (last) { has_next = S.fetch(nxt); nA = has_next ? (const char*)g.A + (size_t)nxt.pm * tstep : cA; nB = has_next ? (const char*)g.Bt + (size_t)nxt.pn * tstep : cB; } }
            const char* a1 = cA + (size_t)(t + 1) * kstep;
            const char* a2 = last ? nA : cA + (size_t)(t + 2) * kstep; const char* b2 = last ? nB : cB + (size_t)(t + 2) * kstep;
            const char* a3 = a2 + kstep; const char* b3 = b2 + kstep;
            if (last && has_next) S.a_ready(nxt);
            if constexpr (SP2) {
            PG8_LDB(B0, 0, 0); PG8_LDB(B1, 0, 1); PG8_SCHED; PG8_LDA(At, 0, 0); PG8_STAGE(PG8_SA(1, 1), a1 + hstep, voffA);
            PG8_WAIT_V(8); PG8_WAIT_L(0); PG8_BAR; PG8_MMA(0, 0, At, B0); PG8_MMA(0, 1, At, B1); PG8_BAR; PG8_SCHED;
            PG8_LDA(At, 0, 1); PG8_STAGE(PG8_SB(0, 0), b2, voffB); PG8_STAGE(PG8_SB(0, 1), b2 + hstep, voffB); PG8_STAGE(PG8_SA(0, 0), a2, voffA);
            PG8_WAIT_V(8); PG8_WAIT_L(0); PG8_BAR; PG8_MMA(1, 0, At, B0); PG8_MMA(1, 1, At, B1); PG8_BAR; PG8_SCHED;
            PG8_LDB(B0, 1, 0); PG8_LDB(B1, 1, 1); PG8_SCHED; PG8_LDA(At, 1, 0); PG8_STAGE(PG8_SA(0, 1), a2 + hstep, voffA);
            PG8_WAIT_V(8); PG8_WAIT_L(0); PG8_BAR; PG8_MMA(0, 0, At, B0); PG8_MMA(0, 1, At, B1); PG8_BAR; PG8_SCHED;
            PG8_LDA(At, 1, 1); PG8_STAGE(PG8_SB(1, 0), b3, voffB); PG8_STAGE(PG8_SB(1, 1), b3 + hstep, voffB); PG8_STAGE(PG8_SA(1, 0), a3, voffA);
            PG8_WAIT_V(8); PG8_WAIT_L(0); PG8_BAR;
            if constexpr (Epi::RSTD) { if (last) E.rstd_consume(tid, lds); }
            PG8_MMA(1, 0, At, B0); PG8_MMA(1, 1, At, B1); PG8_BAR; PG8_SCHED;
            } else {
            PG8_LDB(B0, 0, 0); PG8_SCHED; PG8_LDA(At, 0, 0); PG8_STAGE(PG8_SA(1, 1), a1 + hstep, voffA);
            PG8_WAIT_L(8); PG8_BAR; PG8_WAIT_L(0); PG8_MMA(0, 0, At, B0); PG8_BAR; PG8_SCHED;
            PG8_LDB(B1, 0, 1); PG8_STAGE(PG8_SB(0, 0), b2, voffB);
            PG8_BAR; PG8_WAIT_L(0); PG8_MMA(0, 1, At, B1); PG8_BAR;
            PG8_LDA(At, 0, 1); PG8_STAGE(PG8_SA(0, 0), a2, voffA);
            PG8_BAR; PG8_WAIT_L(0); PG8_MMA(1, 0, At, B0); PG8_BAR; PG8_SCHED;
            PG8_STAGE(PG8_SB(0, 1), b2 + hstep, voffB);
            PG8_WAIT_V(6); PG8_BAR; PG8_MMA(1, 1, At, B1); PG8_BAR;
            PG8_LDB(B0, 1, 0); PG8_SCHED; PG8_LDA(At, 1, 0); PG8_STAGE(PG8_SA(0, 1), a2 + hstep, voffA);
            PG8_WAIT_L(8); PG8_BAR; PG8_WAIT_L(0); PG8_MMA(0, 0, At, B0); PG8_BAR; PG8_SCHED;
            PG8_LDB(B1, 1, 1); PG8_STAGE(PG8_SB(1, 0), b3, voffB);
            PG8_BAR; PG8_WAIT_L(0); PG8_MMA(0, 1, At, B1); PG8_BAR;
            PG8_LDA(At, 1, 1); PG8_STAGE(PG8_SA(1, 0), a3, voffA);
            PG8_BAR; PG8_WAIT_L(0); PG8_MMA(1, 0, At, B0); PG8_BAR; PG8_SCHED;
            PG8_STAGE(PG8_SB(1, 1), b3 + hstep, voffB);
            PG8_WAIT_V(6); PG8_BAR; PG8_MMA(1, 1, At, B1); PG8_BAR;
            }
        }
        if constexpr (ALIGN_EPI) { if (wr == 0) PG8_BAR; }
        if constexpr (!Epi::AFTER_DRAIN) { E(acc, cur, wr, wc, fr, fq); S.done(cur); }
        if (!has_next) break;
#pragma unroll
        for (int a = 0; a < 2; ++a)
#pragma unroll
            for (int b = 0; b < 2; ++b)
#pragma unroll
                for (int m = 0; m < 4; ++m)
#pragma unroll
                    for (int n = 0; n < 2; ++n) acc[a][b][m][n] = (f32x4){0.f, 0.f, 0.f, 0.f};
        cur = nxt; cA = nA; cB = nB; ++ui;
        if constexpr (ALIGN_EPI) { if (wr == 1) PG8_BAR; }
    }
    PG8_WAIT_V(0);
    if constexpr (!ALIGN_EPI) { if (wr == 0) PG8_BAR; }
    PG8_BAR;
    if constexpr (Epi::AFTER_DRAIN) { E.fused(acc, cur, wr, wc, fr, fq, lds, wid, lane); S.done(cur); }
#undef PG8_SA
#undef PG8_SB
#undef PG8_STAGE
#undef PG8_LDA
#undef PG8_LDB
#undef PG8_MMA
#undef PG8_WAIT_V
#undef PG8_WAIT_L
#undef PG8_BAR
#undef PG8_SCHED
}
}
#define GAS __attribute__((address_space(1)))
#define LAS __attribute__((address_space(3)))
typedef unsigned short bf16;
typedef unsigned v4u __attribute__((ext_vector_type(4)));
typedef float f32x4 __attribute__((ext_vector_type(4)));
typedef short bf16x8 __attribute__((ext_vector_type(8)));
typedef GAS unsigned gu32;
typedef GAS unsigned long long gu64;
#define RLX_AGENT __ATOMIC_RELAXED, __HIP_MEMORY_SCOPE_AGENT
#define LDS_WAIT() asm volatile("s_waitcnt lgkmcnt(0)" ::: "memory")
#define VM_WAIT() asm volatile("s_waitcnt vmcnt(0)" ::: "memory")
__device__ __forceinline__ unsigned long long rt() { return __builtin_amdgcn_s_memrealtime(); }
__device__ __forceinline__ unsigned f2bf(float f) { unsigned u = __builtin_bit_cast(unsigned, f); return (u + 0x7fffu + ((u >> 16) & 1u)) >> 16; }
__device__ __forceinline__ unsigned pk2(float lo, float hi) { return f2bf(lo) | (f2bf(hi) << 16); }

#define XB_TMO      128
#define XB_XCNT(j)  (256  + 64 * (j))
#define XB_XSUB(j)  (1280 + 64 * (j))
#define XB_XGEN(j)  (2304 + 64 * (j))
#define XB_TOP      3328
#define XB_TOPGEN   3392
#define XCD_BAR_WORDS 3456
#define XB_SPIN_CAP (1u << 18)

__device__ __forceinline__ unsigned xb_ld(unsigned* p)              { return __hip_atomic_load(p, __ATOMIC_RELAXED, __HIP_MEMORY_SCOPE_AGENT); }
__device__ __forceinline__ unsigned xb_add(unsigned* p, unsigned v) { return __hip_atomic_fetch_add(p, v, __ATOMIC_RELAXED, __HIP_MEMORY_SCOPE_AGENT); }
__device__ __forceinline__ unsigned xb_xcc_id() { return (unsigned)__builtin_amdgcn_s_getreg((3 << 11) | 20) & 0xFu; }
#define XB_SPIN(cond, bar) do { unsigned _sp = 0; while (cond) { __builtin_amdgcn_s_sleep(1); \
    if ((++_sp & 255u) == 0u) { if (xb_ld(&(bar)[XB_TMO])) break; if (_sp > XB_SPIN_CAP) { atomicAdd(&(bar)[XB_TMO], 1u); break; } } } } while (0)

struct XcdBarrier {
    unsigned* bar; unsigned x;
    volatile LAS unsigned* st;
};

__device__ __forceinline__ XcdBarrier xcd_barrier_post(unsigned* bar, volatile LAS unsigned* st) {
    XcdBarrier b; b.bar = bar; b.x = xb_xcc_id(); b.st = st;
    if (threadIdx.x == 0) (void)xb_add(&bar[XB_XCNT(b.x)], 1u);
    return b;
}
__device__ __forceinline__ void xcd_barrier_complete(unsigned* bar, unsigned x, unsigned& nloc, unsigned& nx) {
    const unsigned G = gridDim.x * gridDim.y * gridDim.z;
    unsigned sum, cnt, mine, sp = 0u;
    for (;;) {
        sum = 0u; cnt = 0u; mine = 0u;
#pragma unroll
        for (unsigned j = 0; j < 16; ++j) { const unsigned c = xb_ld(&bar[XB_XCNT(j)]); sum += c; cnt += (c > 0u) ? 1u : 0u; mine = (j == x) ? c : mine; }
        if (sum == G) break;
        __builtin_amdgcn_s_sleep(1);
        if ((++sp & 255u) == 0u) { if (xb_ld(&bar[XB_TMO])) break; if (sp > XB_SPIN_CAP) { atomicAdd(&bar[XB_TMO], 1u); break; } }
    }
    nloc = mine > 0u ? mine : 1u; nx = cnt > 0u ? cnt : 1u;
}

__device__ __forceinline__ void xcd_barrier(const XcdBarrier& b) {
    asm volatile("s_waitcnt vmcnt(0)" ::: "memory");
    __syncthreads();
    if (threadIdx.x == 0) {
        unsigned* bar = b.bar;
        __builtin_amdgcn_s_waitcnt(0);
        unsigned nloc = b.st[0], nx = b.st[1];
        if (nloc == 0u) { xcd_barrier_complete(bar, b.x, nloc, nx); b.st[0] = nloc; b.st[1] = nx; }
        const unsigned old = xb_add(&bar[XB_XSUB(b.x)], 1u);
        const unsigned gen = old / nloc;
        if (old + 1u == (gen + 1u) * nloc) {
            __builtin_amdgcn_fence(__ATOMIC_RELEASE, "agent");
            asm volatile("s_waitcnt vmcnt(0)" ::: "memory");
            const unsigned og = xb_add(&bar[XB_TOP], 1u);
            const unsigned tg = og / nx;
            if (og + 1u == (tg + 1u) * nx) xb_add(&bar[XB_TOPGEN], 1u);
            else XB_SPIN(xb_ld(&bar[XB_TOPGEN]) == tg, bar);
            __builtin_amdgcn_fence(__ATOMIC_ACQUIRE, "agent");
            xb_add(&bar[XB_XGEN(b.x)], 1u);
            asm volatile("s_waitcnt vmcnt(0)" ::: "memory");
        } else {
            XB_SPIN(xb_ld(&bar[XB_XGEN(b.x)]) == gen, bar);
            __builtin_amdgcn_fence(__ATOMIC_ACQUIRE, "agent");
            asm volatile("s_waitcnt vmcnt(0)" ::: "memory");
        }
    }
    __syncthreads();
}

constexpr int BATCH = 32, SEQ = 2048, DM = 1024, M = BATCH * SEQ;
constexpr int GLA_H = 4, GLA_HK = 128, GLA_HV = 256, GLA_RANK = 16, GLA_CHUNK = 64, GLA_IN = 3088, GLA_NP = 3328;
constexpr int SB_N = 3072;
constexpr int DFF = 2816;
constexpr float EPS = 1e-6f, LOG2E = 1.4426950408889634f;
constexpr int NWAVES = 8;

constexpr size_t MiB = 1u << 20;
constexpr size_t WS_CTL = 0, CTL_ZERO_BYTES = 1 * MiB;
constexpr size_t WS_GLA_WIN = 2 * MiB;
constexpr size_t WS_GLA_WOUT = 16 * MiB;
constexpr size_t WS_SB_WIN = 20 * MiB;
constexpr size_t WS_SB_WOUT = 32 * MiB;
constexpr size_t WS_WGU = 36 * MiB;
constexpr size_t WS_WD = 80 * MiB;
constexpr size_t WS_ROWSS = 104 * MiB;
constexpr size_t WS_XB = 108 * MiB;
constexpr size_t WS_OG = 236 * MiB;
constexpr size_t WS_PROJ = 364 * MiB;
constexpr size_t WS_END = 780 * MiB;
constexpr int CW_BAR = 4096;
constexpr int CW_DYN = 16384;

constexpr int RING_BYTES = 131072;
constexpr int LDSCTL_OFF = RING_BYTES, MISC_OFF = LDSCTL_OFF + 320;
constexpr int LDS_BYTES = 163840;

__device__ __forceinline__ float wave_sum(float v) {
#pragma unroll
    for (int o = 1; o < 64; o <<= 1) v += __shfl_xor(v, o);
    return v;
}
__device__ __forceinline__ unsigned cvtpk(float lo, float hi) { unsigned r; asm("v_cvt_pk_bf16_f32 %0, %1, %2" : "=v"(r) : "v"(lo), "v"(hi)); return r; }
__device__ __forceinline__ float bf2f(unsigned short b) { return __uint_as_float(((unsigned)b) << 16); }
__device__ __forceinline__ void glds16(const void* g, unsigned lds_base) {
    unsigned sv; asm volatile("s_mov_b32 %0, m0\n\ts_mov_b32 m0, %2\n\ts_nop 0\n\tglobal_load_lds_dwordx4 %1, off\n\ts_mov_b32 m0, %0" : "=&s"(sv) : "v"(g), "s"(lds_base) : "memory"); }
typedef short s16x4 __attribute__((ext_vector_type(4)));
typedef float f32x16 __attribute__((ext_vector_type(16)));
typedef unsigned u32x2 __attribute__((ext_vector_type(2)));
typedef LAS const char* lds_cptr;
__device__ __forceinline__ s16x4 vtr(lds_cptr p) { return __builtin_bit_cast(s16x4, __builtin_amdgcn_ds_read_tr16_b64_v4i16((LAS s16x4*)p)); }
__device__ __forceinline__ bf16x8 cat8(s16x4 a, s16x4 b) { return (bf16x8){a[0], a[1], a[2], a[3], b[0], b[1], b[2], b[3]}; }
__device__ __forceinline__ int crow(int r, int hi) { return (r & 3) + 8 * (r >> 2) + 4 * hi; }
#define MFMA32(a, b, c) __builtin_amdgcn_mfma_f32_32x32x16_bf16((a), (b), (c), 0, 0, 0)
#define WG_BAR() asm volatile("s_waitcnt vmcnt(0) lgkmcnt(0)\n\ts_barrier" ::: "memory")
__device__ __forceinline__ bf16x8 pk8(const f32x16& x, int s) {
    v4u p; p.x = cvtpk(x[8 * s], x[8 * s + 1]); p.y = cvtpk(x[8 * s + 2], x[8 * s + 3]); p.z = cvtpk(x[8 * s + 4], x[8 * s + 5]); p.w = cvtpk(x[8 * s + 6], x[8 * s + 7]);
    return __builtin_bit_cast(bf16x8, p); }

__device__ __forceinline__ void wt_item(const float* W, int ldw, int c0, int nvalid, const float* g, bf16* WT, int K, int n0, int k0, LAS float* scr, int lane) {
    const int n = lane & 31;
#pragma unroll 8
    for (int i = 0; i < 32; ++i) { const int kk = 2 * i + (lane >> 5); float v = 0.f; if (n < nvalid) v = W[(size_t)(k0 + kk) * ldw + c0 + n]; if (g) v *= g[k0 + kk]; scr[kk * 33 + n] = v; }
    LDS_WAIT(); asm volatile("" ::: "memory");
    const int c = lane & 7;
#pragma unroll
    for (int j = 0; j < 4; ++j) { const int nn = (lane >> 3) + 8 * j; const LAS float* s = scr + (8 * c) * 33 + nn;
        v4u o; o.x = pk2(s[0 * 33], s[1 * 33]); o.y = pk2(s[2 * 33], s[3 * 33]); o.z = pk2(s[4 * 33], s[5 * 33]); o.w = pk2(s[6 * 33], s[7 * 33]);
        *(v4u*)(WT + (size_t)(n0 + nn) * K + k0 + 8 * c) = o; }
    LDS_WAIT(); asm volatile("" ::: "memory");
}
struct Ptrs {
    const float *x, *attn_g, *ffn_g, *gla_win, *gla_w2, *gla_b, *gla_ng, *gla_wout, *sb_win, *sb_qg, *sb_kg, *sb_wout, *wgu, *wd;
    float* out; unsigned char* ws;
};
__device__ __forceinline__ void wt_convert(const Ptrs& P, LAS unsigned char* lds, int gw, int NGW, int wave, int lane, int stage) {
    LAS float* scr = (LAS float*)(lds + wave * 16384);
    constexpr int I_GW = 16 * (GLA_NP / 32), I_O = 16 * 32, I_SW = 16 * (SB_N / 32), I_GU = 16 * (2 * DFF / 32), I_D = (DFF / 64) * 32;
    constexpr int NITEMS = 2 * I_GW + 2 * I_O + 2 * I_SW + 2 * I_O + 4 * I_GU + 4 * I_D;
    for (int it = gw; it < NITEMS; it += NGW) {
        int r = it;
        { int st; if (r < I_GW) st = 0; else if (r < 2 * I_GW + 2 * I_O) st = 1; else { int q = r - (2 * I_GW + 2 * I_O);
            if (q < 2 * I_SW) st = q < I_SW ? 1 : 2; else { q -= 2 * I_SW; if (q < 2 * I_O) st = q < I_O ? 1 : 2; else { q -= 2 * I_O; if (q < 4 * I_GU) st = q < 3 * I_GU ? 1 : 2; else { q -= 4 * I_GU; st = q < 3 * I_D ? 1 : 2; } } } }
          if (st != stage) continue; }
        if (r < 2 * I_GW) { const int j = r / I_GW; r -= j * I_GW; const int nblk = GLA_NP / 32, kb = r / nblk, nb = r % nblk, n0 = 32 * nb; int nv = GLA_IN - n0; nv = nv < 0 ? 0 : (nv > 32 ? 32 : nv);
            wt_item(P.gla_win + (size_t)j * DM * GLA_IN, GLA_IN, n0, nv, P.attn_g + (2 * j) * DM, (bf16*)(P.ws + WS_GLA_WIN + (size_t)j * 7 * MiB), DM, n0, 64 * kb, scr, lane); continue; } r -= 2 * I_GW;
        if (r < 2 * I_O) { const int j = r / I_O; r -= j * I_O; const int kb = r / 32, nb = r % 32;
            wt_item(P.gla_wout + (size_t)j * DM * DM, DM, 32 * nb, 32, nullptr, (bf16*)(P.ws + WS_GLA_WOUT + (size_t)j * 2 * MiB), DM, 32 * nb, 64 * kb, scr, lane); continue; } r -= 2 * I_O;
        if (r < 2 * I_SW) { const int j = r / I_SW; r -= j * I_SW; const int nblk = SB_N / 32, kb = r / nblk, nb = r % nblk, n0 = 32 * nb;
            const int pn = n0 >> 8, p = n0 & 255, bj = p >> 7, wc = (p & 127) >> 5, c0 = 256 * pn + 64 * wc + 32 * bj;
            wt_item(P.sb_win + (size_t)j * DM * SB_N, SB_N, c0, 32, P.attn_g + (2 * j + 1) * DM, (bf16*)(P.ws + WS_SB_WIN + (size_t)j * 6 * MiB), DM, n0, 64 * kb, scr, lane); continue; } r -= 2 * I_SW;
        if (r < 2 * I_O) { const int j = r / I_O; r -= j * I_O; const int kb = r / 32, nb = r % 32;
            wt_item(P.sb_wout + (size_t)j * DM * DM, DM, 32 * nb, 32, nullptr, (bf16*)(P.ws + WS_SB_WOUT + (size_t)j * 2 * MiB), DM, 32 * nb, 64 * kb, scr, lane); continue; } r -= 2 * I_O;
        if (r < 4 * I_GU) { const int i = r / I_GU; r -= i * I_GU; const int nblk = 2 * DFF / 32, kb = r / nblk, nb = r % nblk, n0 = 32 * nb;
            const int pn = n0 >> 8, p = n0 & 255, bj = p >> 7, y = p & 127, c0 = bj * DFF + 128 * pn + y;
            wt_item(P.wgu + (size_t)i * DM * 2 * DFF, 2 * DFF, c0, 32, P.ffn_g + i * DM, (bf16*)(P.ws + WS_WGU + (size_t)i * 11 * MiB), DM, n0, 64 * kb, scr, lane); continue; } r -= 4 * I_GU;
        { const int i = r / I_D; r -= i * I_D; const int kb = r / 32, nb = r % 32;
            wt_item(P.wd + (size_t)i * DFF * DM, DM, 32 * nb, 32, nullptr, (bf16*)(P.ws + WS_WD + (size_t)i * 6 * MiB), DFF, 32 * nb, 64 * kb, scr, lane); }
    }
}
__device__ __forceinline__ void p0_prologue(const Ptrs& P, LAS unsigned char* lds, int vcu, int G, int wave, int lane) {
    const int gw = vcu * NWAVES + wave, NGW = G * NWAVES;
    wt_convert(P, lds, gw, NGW, wave, lane, 0);
    bf16* xb = (bf16*)(P.ws + WS_XB); float* rowss = (float*)(P.ws + WS_ROWSS);
    for (int m = gw; m < M; m += NGW) {
        const f32x4* xr = (const f32x4*)(P.x + (size_t)m * DM) + lane; f32x4 v[4]; float s = 0.f;
#pragma unroll
        for (int j = 0; j < 4; ++j) { v[j] = xr[64 * j]; s += (v[j][0] * v[j][0] + v[j][1] * v[j][1]) + (v[j][2] * v[j][2] + v[j][3] * v[j][3]); }
        s = wave_sum(s);
        u32x2* o8 = (u32x2*)(xb + (size_t)m * DM) + lane;
#pragma unroll
        for (int j = 0; j < 4; ++j) { u32x2 w; w.x = cvtpk(v[j][0], v[j][1]); w.y = cvtpk(v[j][2], v[j][3]); o8[64 * j] = w; }
        if (lane < 16) rowss[(size_t)m * 16 + lane] = lane == 0 ? s : 0.f;
    }
}

namespace sbp {
constexpr int SLOTB = 8192, NSLOT = 5, LDS_K = 0, LDS_V = NSLOT * SLOTB, LDS_OST = 2 * NSLOT * SLOTB, LDS_FLAG = LDS_OST + 8 * 4096, LDS_END = LDS_FLAG + 64;
static_assert(LDS_END <= RING_BYTES, "SB LDS map");
template <bool EARLY>
__device__ __forceinline__ void sb_unit(int b, int h, int qb, const bf16* QKV, bf16* O, LAS unsigned char* lds) {
    int tid_ = threadIdx.x; asm volatile("" : "+v"(tid_));
    const int tid = tid_, lane = tid & 63, r32 = lane & 31, hi = lane >> 5; const int wid = __builtin_amdgcn_readfirstlane(tid >> 6);
    const long rowbase = (long)b * SEQ; const int q0 = qb * 256, jb0 = 4 * qb;
    const bf16* Qw = QKV + (rowbase + q0 + wid * 32) * SB_N + h * 64;
    const bf16* Kb = QKV + rowbase * SB_N + 1024 + h * 64; const bf16* Vb = Kb + 1024;
    const unsigned lds0 = (unsigned)(uintptr_t)lds;
    const bf16* ksrc = Kb + (long)lane * SB_N + wid * 8;
    const bf16* vsrc = Vb + (long)(16 * (wid & 3) + (lane >> 2)) * SB_N + (wid >> 2) * 32 + (lane & 3) * 8;
    const unsigned kdst = lds0 + LDS_K + wid * 1024, vdst = lds0 + LDS_V + wid * 1024;
#define SB_DMA(j) do { const int sl_ = (j) % NSLOT; glds16(ksrc + (long)(j) * 64 * SB_N, (unsigned)__builtin_amdgcn_readfirstlane(kdst + sl_ * SLOTB)); \
                       glds16(vsrc + (long)(j) * 64 * SB_N, (unsigned)__builtin_amdgcn_readfirstlane(vdst + sl_ * SLOTB)); } while (0)
    LAS unsigned* flags = (LAS unsigned*)(lds + LDS_FLAG);
    if (lane == 0) flags[wid] = 0u;
    SB_DMA(jb0); SB_DMA(jb0 + 1); SB_DMA(jb0 + 2); SB_DMA(jb0 + 3);
    bf16x8 qr[4];
#pragma unroll
    for (int d0 = 0; d0 < 4; ++d0) qr[d0] = *(const bf16x8*)(Qw + (long)r32 * SB_N + d0 * 16 + hi * 8);
    f32x16 o0, o1;
#pragma unroll
    for (int r = 0; r < 16; ++r) { o0[r] = 0.f; o1[r] = 0.f; }
    float prun = 1.f;
    const int qw0 = q0 + wid * 32, tq = qw0 + r32, jd = jb0 + (wid >> 1);
    bool wdone = false;
    const int NS = jb0 + 4;
    for (int t = 0; t < NS; ++t) {
        const int par = t & 1;
        WG_BAR();
        { const v4u f0 = *(LAS v4u*)(flags + 8 * par), f1 = *(LAS v4u*)(flags + 8 * par + 4);
          if ((f0.x & f0.y & f0.z & f0.w & f1.x & f1.y & f1.z & f1.w) != 0u) break; }
        if (jb0 - t - 1 >= 0) SB_DMA(jb0 - t - 1);
        const int j = jd - t;
        if (!wdone && j >= 0) {
            const int slot = j % NSLOT, k0 = 64 * j;
            lds_cptr kp = (lds_cptr)lds + LDS_K + slot * SLOTB + hi * 1024 + r32 * 16;
            f32x16 p0, p1;
#pragma unroll
            for (int r = 0; r < 16; ++r) { p0[r] = 0.f; p1[r] = 0.f; }
#pragma unroll
            for (int d0 = 0; d0 < 4; ++d0) { const bf16x8 ka = *(LAS const bf16x8*)(kp + d0 * 2048), kb = *(LAS const bf16x8*)(kp + d0 * 2048 + 512);
                p0 = MFMA32(ka, qr[d0], p0); p1 = MFMA32(kb, qr[d0], p1); }
#pragma unroll
            for (int r = 0; r < 16; ++r) {
                float fa = __builtin_amdgcn_rcpf(1.0f + __builtin_amdgcn_exp2f(p0[r])), fb = __builtin_amdgcn_rcpf(1.0f + __builtin_amdgcn_exp2f(p1[r]));
                if (t == 0) { const int key = k0 + crow(r, hi); if (key >= tq) fa = 1.f; if (key + 32 >= tq) fb = 1.f; }
                p0[r] = fa; p1[r] = fb; }
            float pt[8], pp[8];
#pragma unroll
            for (int g = 0; g < 8; ++g) { const float gpv = g < 4 ? (p0[4 * g] * p0[4 * g + 1]) * (p0[4 * g + 2] * p0[4 * g + 3]) : (p1[4 * g - 16] * p1[4 * g - 15]) * (p1[4 * g - 14] * p1[4 * g - 13]);
                auto rr = __builtin_amdgcn_permlane32_swap(__float_as_uint(gpv), __float_as_uint(gpv), false, false);
                const float a = __uint_as_float(rr[0]), c = __uint_as_float(rr[1]); pp[g] = a * c; pt[g] = hi ? 1.0f : c; }
            float Y = prun, X[8];
#pragma unroll
            for (int g = 7; g >= 0; --g) { X[g] = Y * pt[g]; Y = Y * pp[g]; }
            prun = Y;
#pragma unroll
            for (int g = 0; g < 4; ++g) {
                float E = X[g];
#pragma unroll
                for (int i = 3; i >= 0; --i) { const float tt = E * p0[4 * g + i]; p0[4 * g + i] = E - tt; E = tt; }
                E = X[4 + g];
#pragma unroll
                for (int i = 3; i >= 0; --i) { const float tt = E * p1[4 * g + i]; p1[4 * g + i] = E - tt; E = tt; }
            }
            if (EARLY) wdone = __all(prun == 0.0f) != 0;
            const bf16x8 pw0 = pk8(p0, 0), pw1 = pk8(p0, 1), pw2 = pk8(p1, 0), pw3 = pk8(p1, 1);
            lds_cptr vp = (lds_cptr)lds + LDS_V + slot * SLOTB + ((lane >> 4) & 1) * 32 + (lane & 3) * 8 + (4 * hi + ((lane & 15) >> 2)) * 64;
#define SB_VF(dh, s) cat8(vtr(vp + (dh) * 4096 + (s) * 1024), vtr(vp + (dh) * 4096 + (s) * 1024 + 512))
            o0 = MFMA32(pw0, SB_VF(0, 0), o0); o1 = MFMA32(pw0, SB_VF(1, 0), o1);
            o0 = MFMA32(pw1, SB_VF(0, 1), o0); o1 = MFMA32(pw1, SB_VF(1, 1), o1);
            o0 = MFMA32(pw2, SB_VF(0, 2), o0); o1 = MFMA32(pw2, SB_VF(1, 2), o1);
            o0 = MFMA32(pw3, SB_VF(0, 3), o0); o1 = MFMA32(pw3, SB_VF(1, 3), o1);
#undef SB_VF
        }
        if (lane == 0) flags[8 * (par ^ 1) + wid] = (wdone || j <= 0) ? 1u : 0u;
    }
    bf16* Ow = O + (rowbase + q0 + wid * 32) * DM + h * 64; LAS bf16* stg = (LAS bf16*)(lds + LDS_OST) + wid * 2048;
#pragma unroll
    for (int r = 0; r < 16; ++r) { const int orow = crow(r, hi); stg[orow * 64 + r32] = (bf16)f2bf(o0[r]); stg[orow * 64 + 32 + r32] = (bf16)f2bf(o1[r]); }
    LDS_WAIT();
#pragma unroll
    for (int i = 0; i < 4; ++i) { const int row = i * 8 + (lane >> 3), ch = lane & 7; *(v4u*)(Ow + (long)row * DM + ch * 8) = *(LAS const v4u*)(stg + row * 64 + ch * 8); }
    WG_BAR();
#undef SB_DMA
}
}

namespace glp {
constexpr int PQ = 272, PT = 144;
constexpr int L_QI = 0, L_KI = L_QI + 64 * PQ, L_KT = L_KI + 64 * PQ, L_VI = 53248, L_QR = L_VI + 32768, L_KR = L_QR + 16384, L_GLR = L_KR + 16384, L_DEC = L_GLR + 2048, L_SS = L_DEC + 512, L_GN = L_SS + 4096, L_END = L_GN + 1024;
static_assert(L_KT + 128 * PT <= L_VI && L_END <= RING_BYTES, "GLA LDS map");
__device__ __forceinline__ int permk(int k) { const int x = k & 15; return (k & ~15) | (x & 3) | (((x >> 3) & 1) << 2) | (((x >> 2) & 1) << 3); }
__device__ __forceinline__ void gla_seq(int b, int h, const bf16* proj, const float* w2, const float* bg, const float* gnorm, bf16* og, LAS unsigned char* lds) {
    const int wid = __builtin_amdgcn_readfirstlane(threadIdx.x >> 6);
    const unsigned lds0 = (unsigned)(uintptr_t)lds;
    const int tt_w = wid >> 2, kt_w = wid & 3;
    bf16x8 w2f; float bgv;
    { int lane0 = threadIdx.x & 63; asm volatile("" : "+v"(lane0)); const int kcol = h * 128 + 32 * kt_w + (lane0 & 31), j0 = 8 * (lane0 >> 5);
      v4u p; p.x = pk2(w2[(j0 + 0) * 512 + kcol], w2[(j0 + 1) * 512 + kcol]); p.y = pk2(w2[(j0 + 2) * 512 + kcol], w2[(j0 + 3) * 512 + kcol]);
      p.z = pk2(w2[(j0 + 4) * 512 + kcol], w2[(j0 + 5) * 512 + kcol]); p.w = pk2(w2[(j0 + 6) * 512 + kcol], w2[(j0 + 7) * 512 + kcol]); w2f = __builtin_bit_cast(bf16x8, p); bgv = bg[kcol]; }
    { int tid0 = threadIdx.x; asm volatile("" : "+v"(tid0)); if (tid0 < 256) ((LAS float*)(lds + L_GN))[tid0] = gnorm[tid0]; }
    f32x16 S[4];
#pragma unroll
    for (int kt = 0; kt < 4; ++kt)
#pragma unroll
        for (int r = 0; r < 16; ++r) S[kt][r] = 0.f;
    f32x16 OT0, OT1;
    u32x2 rg[2][4];
#pragma unroll
    for (int r = 0; r < 16; ++r) { OT0[r] = 0.f; OT1[r] = 0.f; }
#pragma unroll
    for (int tt = 0; tt < 2; ++tt)
#pragma unroll
        for (int g = 0; g < 4; ++g) rg[tt][g] = (u32x2){0u, 0u};
    const float qscale = 0.08838834764831845f;
    constexpr int NCH = SEQ / GLA_CHUNK;
    const long tokb = (long)b * SEQ;
#define GLA_REQ_QKG(cc, lane_) do { const long t0_ = tokb + (long)(cc) * GLA_CHUNK; \
        _Pragma("unroll") for (int i_ = 0; i_ < 2; ++i_) { const bf16* src_ = proj + (t0_ + 8 * wid + 4 * i_ + ((lane_) >> 4)) * GLA_NP + h * 128 + 8 * ((lane_) & 15); \
            glds16(src_, (unsigned)__builtin_amdgcn_readfirstlane(lds0 + L_QR + (8 * wid + 4 * i_) * 256)); glds16(src_ + 512, (unsigned)__builtin_amdgcn_readfirstlane(lds0 + L_KR + (8 * wid + 4 * i_) * 256)); } \
        if (wid < 2) glds16(proj + (t0_ + 32 * wid + ((lane_) >> 1)) * GLA_NP + 3072 + 8 * ((lane_) & 1), (unsigned)__builtin_amdgcn_readfirstlane(lds0 + L_GLR + wid * 1024)); } while (0)
#define GLA_REQ_V(cc, lane_) do { const long t0_ = tokb + (long)(cc) * GLA_CHUNK; \
        _Pragma("unroll") for (int tb_ = 0; tb_ < 4; ++tb_) glds16(proj + (t0_ + 16 * tb_ + ((lane_) >> 2)) * GLA_NP + 1024 + h * 256 + 32 * wid + 8 * ((lane_) & 3), (unsigned)__builtin_amdgcn_readfirstlane(lds0 + L_VI + wid * 4096 + tb_ * 1024)); } while (0)
    { int lane0 = threadIdx.x & 63; asm volatile("" : "+v"(lane0)); GLA_REQ_QKG(0, lane0); GLA_REQ_V(0, lane0); }
    for (int c = 0; c <= NCH; ++c) {
        int lane = threadIdx.x & 63; asm volatile("" : "+v"(lane));
        const int r32 = lane & 31, hi = lane >> 5;
        asm volatile("s_waitcnt vmcnt(4) lgkmcnt(0)\n\ts_barrier" ::: "memory");
        if (c > 0) {
            const long tok0 = tokb + (long)(c - 1) * GLA_CHUNK;
            const LAS float* ssb = (const LAS float*)(lds + L_SS);
            float t0 = 0.f, t1 = 0.f;
#pragma unroll
            for (int i = 0; i < 16; ++i) { t0 += ssb[i * 64 + r32]; t1 += ssb[i * 64 + 32 + r32]; }
            const float rs0 = __builtin_amdgcn_rsqf(t0 * (1.0f / 256.0f) + EPS), rs1 = __builtin_amdgcn_rsqf(t1 * (1.0f / 256.0f) + EPS);
#pragma unroll
            for (int g = 0; g < 4; ++g) { const int v0 = 32 * wid + 8 * g + 4 * hi;
#pragma unroll
                for (int tt = 0; tt < 2; ++tt) { const long tok = tok0 + 32 * tt + r32; const float rs = tt ? rs1 : rs0;
                    const f32x4 y = (tt ? (f32x4){OT1[4 * g], OT1[4 * g + 1], OT1[4 * g + 2], OT1[4 * g + 3]} : (f32x4){OT0[4 * g], OT0[4 * g + 1], OT0[4 * g + 2], OT0[4 * g + 3]}) * rs;
                    u32x2 w; w.x = cvtpk(y[0], y[1]); w.y = cvtpk(y[2], y[3]);
                    *(u32x2*)(og + tok * DM + h * 256 + v0) = w; } }
        }
        if (c == NCH) break;
        const long tok0 = tokb + (long)c * GLA_CHUNK;
        {
            f32x16 Z0, Z1;
#pragma unroll
            for (int r = 0; r < 16; ++r) { Z0[r] = bgv; Z1[r] = bgv; }
            const bf16x8 ga0 = *(LAS const bf16x8*)(lds + L_GLR + r32 * 32 + hi * 16), ga1 = *(LAS const bf16x8*)(lds + L_GLR + (32 + r32) * 32 + hi * 16);
            Z0 = MFMA32(ga0, w2f, Z0); Z1 = MFMA32(ga1, w2f, Z1);
#pragma unroll
            for (int r = 0; r < 16; r += 4) {
                f32x4 a, c2;
#pragma unroll
                for (int e = 0; e < 4; ++e) { a[e] = __builtin_amdgcn_fmed3f(Z0[r + e], -80.f, 80.f) * (-LOG2E); c2[e] = __builtin_amdgcn_fmed3f(Z1[r + e], -80.f, 80.f) * (-LOG2E); }
#pragma unroll
                for (int e = 0; e < 4; ++e) { a[e] = __builtin_amdgcn_exp2f(a[e]); c2[e] = __builtin_amdgcn_exp2f(c2[e]); }
                a = a + 1.0f; c2 = c2 + 1.0f;
#pragma unroll
                for (int e = 0; e < 4; ++e) { a[e] = __builtin_amdgcn_logf(a[e]); c2[e] = __builtin_amdgcn_logf(c2[e]); }
#pragma unroll
                for (int e = 0; e < 4; ++e) { Z0[r + e] = a[e] * (-1.0f / 16.0f); Z1[r + e] = c2[e] * (-1.0f / 16.0f); } }
            const bf16x8 la00 = pk8(Z0, 0), la01 = pk8(Z0, 1), la10 = pk8(Z1, 0), la11 = pk8(Z1, 1);
            bf16x8 tri0, tri1, ones;
            { v4u o; o.x = o.y = o.z = o.w = 0x3f803f80u; ones = __builtin_bit_cast(bf16x8, o);
              short e0[8], e1[8];
#pragma unroll
              for (int j = 0; j < 8; ++j) { const int tp = 8 * (j >> 2) + 4 * hi + (j & 3); e0[j] = (tp <= r32) ? (short)0x3f80 : (short)0; e1[j] = (16 + tp <= r32) ? (short)0x3f80 : (short)0; }
              tri0 = (bf16x8){e0[0], e0[1], e0[2], e0[3], e0[4], e0[5], e0[6], e0[7]}; tri1 = (bf16x8){e1[0], e1[1], e1[2], e1[3], e1[4], e1[5], e1[6], e1[7]}; }
            f32x16 T0, T1, BC; const f32x16 zero16 = {0.f, 0.f, 0.f, 0.f, 0.f, 0.f, 0.f, 0.f, 0.f, 0.f, 0.f, 0.f, 0.f, 0.f, 0.f, 0.f};
            T0 = MFMA32(ones, la00, zero16); T0 = MFMA32(ones, la01, T0);
            T1 = MFMA32(ones, la10, zero16); T1 = MFMA32(ones, la11, T1);
            if (tt_w == 0) { BC = MFMA32(tri0, la00, zero16); BC = MFMA32(tri1, la01, BC); }
            else { BC = MFMA32(tri0, la10, T0); BC = MFMA32(tri1, la11, BC); }
            const float blast = T0[0] + T1[0], eblast = __builtin_amdgcn_exp2f(blast);
            const int kcol = 32 * kt_w + r32, pk_ = permk(kcol), tb = 32 * tt_w + 4 * hi;
            const LAS bf16* qrp = (const LAS bf16*)(lds + L_QR + tb * 256 + kcol * 2); const LAS bf16* krp = (const LAS bf16*)(lds + L_KR + tb * 256 + kcol * 2);
            LAS bf16* qip = (LAS bf16*)(lds + L_QI + tb * PQ + pk_ * 2); LAS bf16* kip = (LAS bf16*)(lds + L_KI + tb * PQ + pk_ * 2);
            LAS u32x2* ktp_w = (LAS u32x2*)(lds + L_KT + kcol * PT + tb * 2);
#pragma unroll
            for (int g = 0; g < 4; ++g) {
                f32x4 eb, ei, qv4, kv4;
#pragma unroll
                for (int e = 0; e < 4; ++e) { qv4[e] = bf2f(qrp[(8 * g + e) * 128]); kv4[e] = bf2f(krp[(8 * g + e) * 128]); }
#pragma unroll
                for (int e = 0; e < 4; ++e) eb[e] = __builtin_amdgcn_exp2f(BC[4 * g + e]);
#pragma unroll
                for (int e = 0; e < 4; ++e) ei[e] = __builtin_amdgcn_rcpf(eb[e]);
                const f32x4 qt = qv4 * eb * qscale, kt4 = kv4 * ei, kh = kt4 * eblast;
                const unsigned q01 = cvtpk(qt[0], qt[1]), q23 = cvtpk(qt[2], qt[3]), k01 = cvtpk(kt4[0], kt4[1]), k23 = cvtpk(kt4[2], kt4[3]);
                qip[(8 * g + 0) * (PQ / 2)] = (bf16)(q01 & 0xffffu); qip[(8 * g + 1) * (PQ / 2)] = (bf16)(q01 >> 16); qip[(8 * g + 2) * (PQ / 2)] = (bf16)(q23 & 0xffffu); qip[(8 * g + 3) * (PQ / 2)] = (bf16)(q23 >> 16);
                kip[(8 * g + 0) * (PQ / 2)] = (bf16)(k01 & 0xffffu); kip[(8 * g + 1) * (PQ / 2)] = (bf16)(k01 >> 16); kip[(8 * g + 2) * (PQ / 2)] = (bf16)(k23 & 0xffffu); kip[(8 * g + 3) * (PQ / 2)] = (bf16)(k23 >> 16);
                ktp_w[2 * g] = (u32x2){cvtpk(kh[0], kh[1]), cvtpk(kh[2], kh[3])}; }
            if (tt_w == 0 && hi == 0) ((LAS float*)(lds + L_DEC))[kcol] = eblast;
        }
        if (c == 0) asm volatile("s_waitcnt vmcnt(0) lgkmcnt(0)\n\ts_barrier" ::: "memory");
        else asm volatile("s_waitcnt vmcnt(8) lgkmcnt(0)\n\ts_barrier" ::: "memory");
        if (c + 1 < NCH) GLA_REQ_QKG(c + 1, lane);
#pragma unroll
        for (int tt = 0; tt < 2; ++tt)
#pragma unroll
            for (int g = 0; g < 4; ++g) rg[tt][g] = *(const u32x2*)(proj + (tok0 + 32 * tt + r32) * GLA_NP + 2048 + h * 256 + 32 * wid + 8 * g + 4 * hi);
        f32x16 X00, X01, X11; const f32x16 zero16m = {0.f, 0.f, 0.f, 0.f, 0.f, 0.f, 0.f, 0.f, 0.f, 0.f, 0.f, 0.f, 0.f, 0.f, 0.f, 0.f};
        lds_cptr qi = (lds_cptr)lds + L_QI + r32 * PQ + hi * 16, ki = (lds_cptr)lds + L_KI + r32 * PQ + hi * 16;
#pragma unroll
        for (int ks = 0; ks < 8; ++ks) {
            const bf16x8 a0 = *(LAS const bf16x8*)(ki + ks * 32), a1 = *(LAS const bf16x8*)(ki + 32 * PQ + ks * 32);
            const bf16x8 b0 = *(LAS const bf16x8*)(qi + ks * 32), b1 = *(LAS const bf16x8*)(qi + 32 * PQ + ks * 32);
            if (ks == 0) { X00 = MFMA32(a0, b0, zero16m); X01 = MFMA32(a0, b1, zero16m); X11 = MFMA32(a1, b1, zero16m); }
            else { X00 = MFMA32(a0, b0, X00); X01 = MFMA32(a0, b1, X01); X11 = MFMA32(a1, b1, X11); }
            if (ks & 1) __builtin_amdgcn_sched_barrier(0); }
#pragma unroll
        for (int r = 0; r < 16; ++r) if (crow(r, hi) > r32) { X00[r] = 0.f; X11[r] = 0.f; }
        f32x4 sg[2][4];
#pragma unroll
        for (int g = 0; g < 4; ++g) { const f32x4 gn = *(LAS const f32x4*)(lds + L_GN + (32 * wid + 8 * g + 4 * hi) * 4);
#pragma unroll
            for (int tt = 0; tt < 2; ++tt) { const u32x2 rr = rg[tt][g];
                const f32x4 rv = {__uint_as_float(rr.x << 16), __uint_as_float(rr.x & 0xffff0000u), __uint_as_float(rr.y << 16), __uint_as_float(rr.y & 0xffff0000u)};
                f32x4 ex = rv * (-LOG2E);
#pragma unroll
                for (int e = 0; e < 4; ++e) ex[e] = __builtin_amdgcn_exp2f(ex[e]);
                ex = ex + 1.0f;
#pragma unroll
                for (int e = 0; e < 4; ++e) ex[e] = __builtin_amdgcn_rcpf(ex[e]);
                sg[tt][g] = gn * (rv * ex); } }
        lds_cptr vw = (lds_cptr)lds + L_VI + wid * 4096 + ((lane >> 4) & 1) * 32 + (lane & 3) * 8 + ((lane & 15) >> 2) * 64;
#define GL_VA(st, sp) cat8(vtr(vw + (32 * (st) + 16 * (sp) + 4 * hi) * 64), vtr(vw + (32 * (st) + 16 * (sp) + 4 * hi + 8) * 64))
        { const bf16x8 va00 = GL_VA(0, 0), va01 = GL_VA(0, 1), va10 = GL_VA(1, 0), va11 = GL_VA(1, 1);
          OT0 = MFMA32(va00, pk8(X00, 0), zero16m); OT0 = MFMA32(va01, pk8(X00, 1), OT0);
          OT1 = MFMA32(va00, pk8(X01, 0), zero16m); OT1 = MFMA32(va01, pk8(X01, 1), OT1);
          OT1 = MFMA32(va10, pk8(X11, 0), OT1); OT1 = MFMA32(va11, pk8(X11, 1), OT1); }
#undef GL_VA
#pragma unroll
        for (int kt = 0; kt < 4; ++kt)
#pragma unroll
            for (int sp = 0; sp < 2; ++sp) { const bf16x8 sa = pk8(S[kt], sp);
                const bf16x8 bq0 = *(LAS const bf16x8*)(qi + (2 * kt + sp) * 32), bq1 = *(LAS const bf16x8*)(qi + 32 * PQ + (2 * kt + sp) * 32);
                OT0 = MFMA32(sa, bq0, OT0); OT1 = MFMA32(sa, bq1, OT1); }
#pragma unroll
        for (int kt = 0; kt < 4; ++kt)
#pragma unroll
            for (int g = 0; g < 4; ++g) { const f32x4 d4 = *(LAS const f32x4*)(lds + L_DEC + (32 * kt + 8 * g + 4 * hi) * 4);
                S[kt][4 * g] *= d4[0]; S[kt][4 * g + 1] *= d4[1]; S[kt][4 * g + 2] *= d4[2]; S[kt][4 * g + 3] *= d4[3]; }
        lds_cptr ktp = (lds_cptr)lds + L_KT + r32 * PT + hi * 16;
#pragma unroll
        for (int ts = 0; ts < 4; ++ts) { const bf16x8 vb = cat8(vtr(vw + (16 * ts + 8 * hi) * 64), vtr(vw + (16 * ts + 8 * hi + 4) * 64));
#pragma unroll
            for (int kt = 0; kt < 4; ++kt) { const bf16x8 ak = *(LAS const bf16x8*)(ktp + kt * 32 * PT + ts * 32); S[kt] = MFMA32(ak, vb, S[kt]); } }
        asm volatile("s_waitcnt lgkmcnt(0)" ::: "memory");
        GLA_REQ_V(c + 1 < NCH ? c + 1 : c, lane);
        { float ss0 = 0.f, ss1 = 0.f;
#pragma unroll
          for (int r = 0; r < 16; ++r) { ss0 += OT0[r] * OT0[r]; ss1 += OT1[r] * OT1[r]; }
          LAS float* ssb = (LAS float*)(lds + L_SS);
          ssb[(wid * 2 + hi) * 64 + r32] = ss0; ssb[(wid * 2 + hi) * 64 + 32 + r32] = ss1; }
#pragma unroll
        for (int g = 0; g < 4; ++g)
#pragma unroll
            for (int e = 0; e < 4; ++e) { OT0[4 * g + e] *= sg[0][g][e]; OT1[4 * g + e] *= sg[1][g][e]; }
    }
    asm volatile("s_waitcnt vmcnt(0) lgkmcnt(0)\n\ts_barrier" ::: "memory");
#undef GLA_REQ_QKG
#undef GLA_REQ_V
}
}

#ifndef SB_EARLY
#define SB_EARLY 1
#endif
struct Args { const float* in[14]; float* out; unsigned char* ws; int ph_lo, ph_hi; };
constexpr int N_PHASES = 21;
typedef __attribute__((address_space(4))) const Args* kargs_t;
__device__ __forceinline__ kargs_t kargs() { kargs_t p = (kargs_t)__builtin_amdgcn_kernarg_segment_ptr(); asm volatile("" : "+s"(p)); return p; }
__global__ void __launch_bounds__(NWAVES * 64, 2) fwd(Args args_unused) {
    extern __shared__ __attribute__((aligned(16))) unsigned char lds_raw[];
    LAS unsigned char* lds = (LAS unsigned char*)lds_raw;
    (void)args_unused;
    { const int tid = threadIdx.x; for (int u = tid; u < (LDS_BYTES - LDSCTL_OFF) / 4; u += NWAVES * 64) ((LAS unsigned*)(lds + LDSCTL_OFF))[u] = 0u; }
    __syncthreads();
    const int lo = kargs()->ph_lo, hi_ = kargs()->ph_hi;
    XcdBarrier bar; bar.bar = (unsigned*)(kargs()->ws + WS_CTL) + CW_BAR; bar.x = 0; bar.st = nullptr;
    if (hi_ - lo > 1) bar = xcd_barrier_post((unsigned*)(kargs()->ws + WS_CTL) + CW_BAR, (volatile LAS unsigned*)(lds + MISC_OFF) + 8);
#ifndef PHASE_MASK
#define PHASE_MASK 0x7ff
#endif
#define IN(k) (lo <= (k) && (k) < hi_)
#define INL(n) (((PHASE_MASK >> ((n) + 1)) & 1) && IN(pb + (n)))
#define SEAM(k) do { if (IN(k) && IN((k) + 1)) xcd_barrier(bar); } while (0)
#define WSP(T, off) ((T*)(A->ws + (off)))
#define GRID_ID const int G = gridDim.x, bx = blockIdx.x

    if ((PHASE_MASK & 1) && IN(0)) { const kargs_t A = kargs(); GRID_ID;
        const int tid = threadIdx.x, lane = tid & 63, wave = __builtin_amdgcn_readfirstlane(tid >> 6), vcu = (G % 8 == 0) ? (bx % 8) * (G / 8) + bx / 8 : bx;
        Ptrs P;
        P.x = A->in[0]; P.attn_g = A->in[1]; P.ffn_g = A->in[2]; P.gla_win = A->in[3]; P.gla_w2 = A->in[4]; P.gla_b = A->in[5]; P.gla_ng = A->in[6]; P.gla_wout = A->in[7];
        P.sb_win = A->in[8]; P.sb_qg = A->in[9]; P.sb_kg = A->in[10]; P.sb_wout = A->in[11]; P.wgu = A->in[12]; P.wd = A->in[13]; P.out = A->out; P.ws = A->ws;
        p0_prologue(P, lds, vcu, G, wave, lane); }
    SEAM(0);
#pragma unroll 1
    for (int jj = 0; jj < 2; ++jj) {
        const int pb = 1 + 10 * jj;
        if (INL(0)) { const kargs_t A = kargs(); GRID_ID; constexpr int PHN = 0; (void)PHN;
            pg8::Gemm g{WSP(const bf16, WS_XB), WSP(const bf16, WS_GLA_WIN + (size_t)jj * 7 * MiB), M, GLA_NP, DM}; pg8::DynOrder S; S.init(M, GLA_NP, G, bx); S.cnt = (unsigned*)(A->ws + WS_CTL) + CW_DYN + (pb + PHN) * 1024; S.slot = (LAS int*)(lds + LDSCTL_OFF + 64);
            pg8::EpiProj<0> E{(LAS float*)(lds + pg8::RSTD_OFF), WSP(bf16, WS_PROJ), GLA_NP, WSP(const float, WS_ROWSS), nullptr, nullptr, 1.f, GLA_IN};
            pg8::gemm_phase<pg8::EpiProj<0>, pg8::DynOrder, true, true>(lds, g, S, E);
        }
        SEAM(pb + 0);
        if (INL(1)) { const kargs_t A = kargs(); GRID_ID; constexpr int PHN = 1; (void)PHN;
            constexpr int NSEQ = BATCH * GLA_H;
            for (int sq = bx; sq < NSEQ; sq += G) glp::gla_seq(sq >> 2, sq & 3, WSP(const bf16, WS_PROJ), A->in[4] + (size_t)jj * GLA_RANK * 512, A->in[5] + jj * 512, A->in[6] + jj * GLA_HV, WSP(bf16, WS_OG), lds);
            if (bx >= NSEQ || G <= NSEQ) { int tid_ = threadIdx.x; asm volatile("" : "+v"(tid_)); const int lane = tid_ & 63, wave = __builtin_amdgcn_readfirstlane(tid_ >> 6);
                Ptrs P; P.x = A->in[0]; P.attn_g = A->in[1]; P.ffn_g = A->in[2]; P.gla_win = A->in[3]; P.gla_w2 = A->in[4]; P.gla_b = A->in[5]; P.gla_ng = A->in[6]; P.gla_wout = A->in[7];
                P.sb_win = A->in[8]; P.sb_qg = A->in[9]; P.sb_kg = A->in[10]; P.sb_wout = A->in[11]; P.wgu = A->in[12]; P.wd = A->in[13]; P.out = A->out; P.ws = A->ws;
                const int nconv = G > NSEQ ? G - NSEQ : G, wg = G > NSEQ ? bx - NSEQ : bx;
                wt_convert(P, lds, wg * NWAVES + wave, nconv * NWAVES, wave, lane, jj + 1); }
        }
        SEAM(pb + 1);
        if (INL(2)) { const kargs_t A = kargs(); GRID_ID; constexpr int PHN = 2; (void)PHN;
            pg8::Gemm g{WSP(const bf16, WS_OG), WSP(const bf16, WS_GLA_WOUT + (size_t)jj * 2 * MiB), M, DM, DM}; pg8::DynOrder S; S.init(M, DM, G, bx); S.cnt = (unsigned*)(A->ws + WS_CTL) + CW_DYN + (pb + PHN) * 1024; S.slot = (LAS int*)(lds + LDSCTL_OFF + 64);
            pg8::EpiResid<false> E{WSP(bf16, WS_XB), nullptr, WSP(float, WS_ROWSS)};
            pg8::gemm_phase<pg8::EpiResid<false>, pg8::DynOrder, true, true>(lds, g, S, E);
        }
        SEAM(pb + 2);
        if (INL(3)) { const kargs_t A = kargs(); GRID_ID; constexpr int PHN = 3; (void)PHN;
            pg8::Gemm g{WSP(const bf16, WS_XB), WSP(const bf16, WS_WGU + (size_t)(2 * jj) * 11 * MiB), M, 2 * DFF, DM}; pg8::DynOrder S; S.init(M, 2 * DFF, G, bx); S.cnt = (unsigned*)(A->ws + WS_CTL) + CW_DYN + (pb + PHN) * 1024; S.slot = (LAS int*)(lds + LDSCTL_OFF + 64);
            pg8::EpiSwiGLU E{WSP(bf16, WS_PROJ), DFF, WSP(const float, WS_ROWSS), (LAS float*)(lds + pg8::RSTD_OFF)};
            pg8::gemm_phase<pg8::EpiSwiGLU, pg8::DynOrder, true, true>(lds, g, S, E);
        }
        SEAM(pb + 3);
        if (INL(4)) { const kargs_t A = kargs(); GRID_ID; constexpr int PHN = 4; (void)PHN;
            pg8::Gemm g{WSP(const bf16, WS_PROJ), WSP(const bf16, WS_WD + (size_t)(2 * jj) * 6 * MiB), M, DM, DFF}; pg8::DynOrder S; S.init(M, DM, G, bx, 1); S.cnt = (unsigned*)(A->ws + WS_CTL) + CW_DYN + (pb + PHN) * 1024; S.slot = (LAS int*)(lds + LDSCTL_OFF + 64);
            pg8::EpiResid<false> E{WSP(bf16, WS_XB), nullptr, WSP(float, WS_ROWSS)};
            pg8::gemm_phase<pg8::EpiResid<false>, pg8::DynOrder, true, true>(lds, g, S, E);
        }
        SEAM(pb + 4);
        if (INL(5)) { const kargs_t A = kargs(); GRID_ID; constexpr int PHN = 5; (void)PHN;
            pg8::Gemm g{WSP(const bf16, WS_XB), WSP(const bf16, WS_SB_WIN + (size_t)jj * 6 * MiB), M, SB_N, DM}; pg8::DynOrder S; S.init(M, SB_N, G, bx); S.cnt = (unsigned*)(A->ws + WS_CTL) + CW_DYN + (pb + PHN) * 1024; S.slot = (LAS int*)(lds + LDSCTL_OFF + 64);
            pg8::EpiProj<1> E{(LAS float*)(lds + pg8::RSTD_OFF), WSP(bf16, WS_PROJ), SB_N, WSP(const float, WS_ROWSS), A->in[9] + jj * 64, A->in[10] + jj * 64, 0.125f * LOG2E, SB_N};
            pg8::gemm_phase<pg8::EpiProj<1>, pg8::DynOrder, true, true>(lds, g, S, E);
        }
        SEAM(pb + 5);
        if (INL(6)) { const kargs_t A = kargs(); GRID_ID; constexpr int PHN = 6; (void)PHN;
            for (int p = bx; p < M / 256; p += G) { const int b = p >> 3, qb = p & 7;
#pragma unroll 1
                for (int hh = 0; hh < 16; ++hh) sbp::sb_unit<SB_EARLY != 0>(b, hh, qb, WSP(const bf16, WS_PROJ), WSP(bf16, WS_OG), lds);
                pg8::Gemm g{WSP(const bf16, WS_OG), WSP(const bf16, WS_SB_WOUT + (size_t)jj * 2 * MiB), M, DM, DM}; pg8::PanelOrder S; S.init(M, DM, G, bx); S.p = p;
                pg8::EpiResid<false> E{WSP(bf16, WS_XB), nullptr, WSP(float, WS_ROWSS)};
                pg8::gemm_phase<pg8::EpiResid<false>, pg8::PanelOrder, true, true>(lds, g, S, E); }
        }
        do { if (IN(pb + 6) && IN(pb + 8)) xcd_barrier(bar); } while (0);
        if (INL(8)) { const kargs_t A = kargs(); GRID_ID; constexpr int PHN = 8; (void)PHN;
            pg8::Gemm g{WSP(const bf16, WS_XB), WSP(const bf16, WS_WGU + (size_t)(2 * jj + 1) * 11 * MiB), M, 2 * DFF, DM}; pg8::DynOrder S; S.init(M, 2 * DFF, G, bx); S.cnt = (unsigned*)(A->ws + WS_CTL) + CW_DYN + (pb + PHN) * 1024; S.slot = (LAS int*)(lds + LDSCTL_OFF + 64);
            pg8::EpiSwiGLU E{WSP(bf16, WS_PROJ), DFF, WSP(const float, WS_ROWSS), (LAS float*)(lds + pg8::RSTD_OFF)};
            pg8::gemm_phase<pg8::EpiSwiGLU, pg8::DynOrder, true, true>(lds, g, S, E);
        }
        SEAM(pb + 8);
        if (INL(9)) { const kargs_t A = kargs(); GRID_ID; constexpr int PHN = 9; (void)PHN;
            pg8::Gemm g{WSP(const bf16, WS_PROJ), WSP(const bf16, WS_WD + (size_t)(2 * jj + 1) * 6 * MiB), M, DM, DFF}; pg8::DynOrder S; S.init(M, DM, G, bx, 1); S.cnt = (unsigned*)(A->ws + WS_CTL) + CW_DYN + (pb + PHN) * 1024; S.slot = (LAS int*)(lds + LDSCTL_OFF + 64);
            if (jj == 0) { pg8::EpiResid<false> E{WSP(bf16, WS_XB), nullptr, WSP(float, WS_ROWSS)}; pg8::gemm_phase<pg8::EpiResid<false>, pg8::DynOrder, true, true>(lds, g, S, E); }
            else { pg8::EpiResid<true> E{WSP(bf16, WS_XB), A->out, nullptr}; pg8::gemm_phase<pg8::EpiResid<true>, pg8::DynOrder, true, true>(lds, g, S, E); }
        }
        SEAM(pb + 9);
    }
#undef IN
#undef INL
#undef SEAM
#undef WSP
#undef GRID_ID
}

#ifndef MK_PER_PHASE
#define MK_PER_PHASE 0
#endif
extern "C" void kernel_launch(void* const* d_in, const int* in_sizes, int n_in, void* d_out, int out_size, void* d_ws, size_t ws_size, hipStream_t stream) {
    static int grid = 0;
    if (grid == 0) {
        if (n_in != 14 || in_sizes[0] != M * DM || out_size != M * DM || ws_size < WS_END) { fprintf(stderr, "kernel_launch: unexpected shapes (n_in %d, in0 %d, out %d, ws %zu)\n", n_in, n_in > 0 ? in_sizes[0] : -1, out_size, ws_size); grid = -1; return; }
        int dev = 0, cus = 0, per_cu = 0;
        if (hipGetDevice(&dev) != hipSuccess || hipDeviceGetAttribute(&cus, hipDeviceAttributeMultiprocessorCount, dev) != hipSuccess) { grid = -1; return; }
        if (hipFuncSetAttribute((const void*)fwd, hipFuncAttributeMaxDynamicSharedMemorySize, LDS_BYTES) != hipSuccess) { fprintf(stderr, "kernel_launch: hipFuncSetAttribute failed\n"); grid = -1; return; }
        if (hipOccupancyMaxActiveBlocksPerMultiprocessor(&per_cu, (const void*)fwd, NWAVES * 64, LDS_BYTES) != hipSuccess || per_cu < 1) { fprintf(stderr, "kernel_launch: occupancy query says %d blocks per CU\n", per_cu); }
        (void)hipGetLastError();
        grid = cus;
    }
    if (grid < 0) return;
    (void)hipMemsetAsync((char*)d_ws + WS_CTL, 0, CTL_ZERO_BYTES, stream);
    Args a{};
    for (int i = 0; i < 14; ++i) a.in[i] = (const float*)d_in[i];
    a.out = (float*)d_out; a.ws = (unsigned char*)d_ws;
#if MK_PER_PHASE
    for (int p = 0; p < N_PHASES; ++p) { a.ph_lo = p; a.ph_hi = p + 1; hipLaunchKernelGGL(fwd, dim3(grid), dim3(NWAVES * 64), LDS_BYTES, stream, a); }
#else
    a.ph_lo = 0; a.ph_hi = N_PHASES;
    hipLaunchKernelGGL(fwd, dim3(grid), dim3(NWAVES * 64), LDS_BYTES, stream, a);
#endif
}
```

```cpp
#include <hip/hip_runtime.h>
#include <cstdio>
#include <cstdint>
namespace pg8 {
#define PG8_LAS __attribute__((address_space(3)))
typedef unsigned short bf16_t;
typedef short bf16x8 __attribute__((ext_vector_type(8)));
typedef float f32x4 __attribute__((ext_vector_type(4)));
typedef unsigned u32x4 __attribute__((ext_vector_type(4)));
constexpr int BM = 256, BK = 64, HALF = 128, HTB = HALF * BK * 2  , STAGE_BYTES = 8 * HTB, NXCD = 8, WGM = 4;

__host__ __device__ __forceinline__ int lds_byte(int r, int c) { const int st = (r >> 4) * 2 + (c >> 5), rr = r & 15, cc = c & 31, ob = rr * 64 + cc * 2; return st * 1024 + (ob ^ (((ob >> 9) & 1) << 5)); }
__host__ __device__ __forceinline__ void stage_rc(int b, int& R, int& C) { const int st = b / 1024, sb = b % 1024, swz = sb ^ (((sb >> 9) & 1) << 5); R = (st >> 1) * 16 + swz / 64; C = (st & 1) * 32 + (swz % 64) / 2; }
__host__ __device__ __forceinline__ int perm32(int rho) { const int n = rho >> 4, i = rho & 15; return 8 * (i >> 2) + 4 * n + (i & 3); }

struct Unit { int pm, pn; };
struct Gemm { const bf16_t* A; const bf16_t* Bt; int M, N, K; };

struct StaticOrder {
    int nM, nN, nwg, G, c, rev;
    __host__ __device__ void init(int M, int N, int G_, int c_, int rev_ = 0) { nM = M / BM; nN = N / BM; nwg = nM * nN; G = G_; c = c_; rev = rev_; }
    __host__ __device__ bool next(int i, Unit& u) const {
        const long L = (long)i * G + c; if (L >= nwg) return false;
        int wgid = (int)L; { const int q = nwg / NXCD, r = nwg % NXCD, xcd = wgid % NXCD, off = wgid / NXCD; wgid = (xcd < r ? xcd * (q + 1) : r * (q + 1) + (xcd - r) * q) + off; }
        const int nig = WGM * nN, gid = wgid / nig, fm = gid * WGM, gsz = (nM - fm) < WGM ? (nM - fm) : WGM;
        u.pm = fm + ((wgid % nig) % gsz); u.pn = (wgid % nig) / gsz; if (rev) u.pm = nM - 1 - u.pm; return true;
    }
    __device__ __forceinline__ void a_ready(const Unit&) const {}
    __device__ __forceinline__ void done(const Unit&) const {}
    static constexpr bool DYNAMIC = false;
    __device__ __forceinline__ unsigned request(int) const { return 0u; }
    __device__ __forceinline__ void resolve(unsigned, int) const {}
    __device__ __forceinline__ bool fetch(Unit&) const { return false; }
    __host__ __device__ void unit_of(int wgid, Unit& u) const { const int nig = WGM * nN, gid = wgid / nig, fm = gid * WGM, gsz = (nM - fm) < WGM ? (nM - fm) : WGM; u.pm = fm + ((wgid % nig) % gsz); u.pn = (wgid % nig) / gsz; if (rev) u.pm = nM - 1 - u.pm; }
};
struct PanelOrder : StaticOrder {
    int p;
    __device__ __forceinline__ bool next(int i, Unit& u) const { int q = p; asm volatile("" : "+s"(q)); u.pm = q; u.pn = i; return i < nN; }
};
struct DynOrder : StaticOrder {
    static constexpr bool DYNAMIC = true;
    unsigned* cnt; PG8_LAS int* slot;
    __device__ __forceinline__ int csize(int x) const { return nwg / NXCD + (x < nwg % NXCD ? 1 : 0); }
    __device__ __forceinline__ int cstart(int x) const { const int q = nwg / NXCD, r = nwg % NXCD; return x < r ? x * (q + 1) : r * (q + 1) + (x - r) * q; }
    __device__ __forceinline__ unsigned request(int tid) const { unsigned tok = 0u; if (tid == 0) tok = __hip_atomic_fetch_add(cnt + 64 * (c & 7), 1u, __ATOMIC_RELAXED, __HIP_MEMORY_SCOPE_AGENT); return tok; }
    __device__ __forceinline__ void resolve(unsigned tok, int tid) const {
        if (tid < 64) { int x0 = c & 7; asm volatile("" : "+s"(x0)); const int ln = (int)__builtin_amdgcn_mbcnt_hi(~0u, __builtin_amdgcn_mbcnt_lo(~0u, 0u));
            const int per = (G + 7) >> 3;
            const int off0 = per + (int)__builtin_amdgcn_readfirstlane(tok); int found = 0, wg = 0;
            if (off0 < csize(x0)) { found = 1; wg = cstart(x0) + off0; }
            else { unsigned seen = 0xffffffffu; if (ln >= 1 && ln < NXCD) seen = __hip_atomic_load(cnt + 64 * ((x0 + ln) & 7), __ATOMIC_RELAXED, __HIP_MEMORY_SCOPE_AGENT);
                const unsigned open = (unsigned)__ballot(seen < (unsigned)(nwg / NXCD - per));
                if (tid == 0) for (int k = 1; k < NXCD; ++k) { const int y = (x0 + k) & 7;
                    if (!found && ((open >> k) & 1u)) { const int off = per + (int)__hip_atomic_fetch_add(cnt + 64 * y, 1u, __ATOMIC_RELAXED, __HIP_MEMORY_SCOPE_AGENT);
                        if (off < csize(y)) { found = 1; wg = cstart(y) + off; } } } }
            if (tid == 0) { Unit u; u.pm = 0; u.pn = 0; if (found) unit_of(wg, u);
                slot[0] = found; slot[1] = u.pm; slot[2] = u.pn; } }
    }
    __device__ __forceinline__ bool fetch(Unit& u) const { const int f = __builtin_amdgcn_readfirstlane(slot[0]); u.pm = __builtin_amdgcn_readfirstlane(slot[1]); u.pn = __builtin_amdgcn_readfirstlane(slot[2]); return f != 0; }
};
struct GlaOutOrder : StaticOrder {
    static constexpr bool DYNAMIC = true;
    unsigned* cnt; PG8_LAS int* slot; unsigned* ready; unsigned* tmo;
    static constexpr int QN = 128;
    __device__ __forceinline__ void map(int x, int i, Unit& u) const { u.pm = (x + 8 * ((i >> 2) & 3)) * 8 + (i >> 4); u.pn = i & 3; }
    __device__ __forceinline__ unsigned request(int tid) const { unsigned tok = 0u; if (tid == 0) tok = __hip_atomic_fetch_add(cnt + 64 * (c & 7), 1u, __ATOMIC_RELAXED, __HIP_MEMORY_SCOPE_AGENT); return tok; }
    __device__ __forceinline__ void resolve(unsigned tok, int tid) const {
        if (tid < 64) { int x0 = c & 7; asm volatile("" : "+s"(x0)); const int ln = (int)__builtin_amdgcn_mbcnt_hi(~0u, __builtin_amdgcn_mbcnt_lo(~0u, 0u));
            const int off0 = (int)__builtin_amdgcn_readfirstlane(tok); int found = 0; Unit u; u.pm = 0; u.pn = 0;
            if (off0 < QN) { found = 1; map(x0, off0, u); }
            else { unsigned seen = 0xffffffffu; if (ln >= 1 && ln < NXCD) seen = __hip_atomic_load(cnt + 64 * ((x0 + ln) & 7), __ATOMIC_RELAXED, __HIP_MEMORY_SCOPE_AGENT);
                const unsigned open = (unsigned)__ballot(seen < (unsigned)QN);
                if (tid == 0) for (int k = 1; k < NXCD; ++k) { const int y = (x0 + k) & 7;
                    if (!found && ((open >> k) & 1u)) { const int off = (int)__hip_atomic_fetch_add(cnt + 64 * y, 1u, __ATOMIC_RELAXED, __HIP_MEMORY_SCOPE_AGENT);
                        if (off < QN) { found = 1; map(y, off, u); } } } }
            if (tid == 0) { slot[0] = found; slot[1] = u.pm; slot[2] = u.pn; } }
    }
    __device__ __forceinline__ bool fetch(Unit& u) const { const int f = __builtin_amdgcn_readfirstlane(slot[0]); u.pm = __builtin_amdgcn_readfirstlane(slot[1]); u.pn = __builtin_amdgcn_readfirstlane(slot[2]); return f != 0; }
    __device__ __forceinline__ bool next(int, Unit& u) const {
        const int tid = threadIdx.x; const unsigned tok = request(tid); resolve(tok, tid);
        asm volatile("s_waitcnt vmcnt(0) lgkmcnt(0)\n\ts_barrier" ::: "memory");
        const bool f = fetch(u);
        asm volatile("s_waitcnt lgkmcnt(0)\n\ts_barrier" ::: "memory");
        return f; }
    __device__ __forceinline__ void a_ready(const Unit& u) const {
        if (threadIdx.x < 64) {
            const unsigned long long t0 = __builtin_amdgcn_s_memrealtime(); unsigned polls = 0;
            while ((unsigned)__builtin_amdgcn_readfirstlane(__hip_atomic_load(ready + 64 * u.pm, __ATOMIC_RELAXED, __HIP_MEMORY_SCOPE_AGENT)) < 4u) {
                if ((++polls & 255u) == 0u && __builtin_amdgcn_readfirstlane(__hip_atomic_load(tmo, __ATOMIC_RELAXED, __HIP_MEMORY_SCOPE_AGENT)) != 0u) break;
                if (__builtin_amdgcn_s_memrealtime() - t0 > 2000000ull) { if (threadIdx.x == 0) __hip_atomic_store(tmo, 1u, __ATOMIC_RELAXED, __HIP_MEMORY_SCOPE_AGENT); break; }
                __builtin_amdgcn_s_sleep(2); }
            __builtin_amdgcn_fence(__ATOMIC_ACQUIRE, "agent");
            asm volatile("s_waitcnt vmcnt(0)" ::: "memory");
        }
        asm volatile("" ::: "memory"); __builtin_amdgcn_s_barrier(); asm volatile("" ::: "memory");
    }
};
__device__ __forceinline__ unsigned cvt_pk_bf16(float lo, float hi) { unsigned r; asm volatile("v_cvt_pk_bf16_f32 %0, %1, %2" : "=v"(r) : "v"(lo), "v"(hi)); return r; }
typedef float f32x2 __attribute__((ext_vector_type(2)));
constexpr float NORM_EPS = 1e-6f;
constexpr float LOG2E_F = 1.4426950408889634f;
__device__ __forceinline__ float row_rstd(const float* rowss, int row, int fq) {
    const f32x4 v = *(const f32x4*)(rowss + (size_t)row * 16 + 4 * fq);
    float s = (v[0] + v[1]) + (v[2] + v[3]);
    s += __shfl_xor(s, 16); s += __shfl_xor(s, 32);
    return __builtin_amdgcn_rsqf(s * (1.0f / 1024.0f) + NORM_EPS);
}
constexpr int RSTD_OFF = STAGE_BYTES + 1024, RSP_OFF = STAGE_BYTES + 2048;
__device__ __forceinline__ void rstd_issue_(const float* rowss, const Unit& u, int wid, int lane, PG8_LAS unsigned char* lds) {
#pragma unroll
    for (int i = 0; i < 2; ++i) { const int rowl = 16 * (2 * wid + i) + (lane >> 2);
        __builtin_amdgcn_global_load_lds((const unsigned*)(rowss + (size_t)(u.pm * BM + rowl) * 16 + 4 * (lane & 3)), (PG8_LAS unsigned*)(lds + RSP_OFF + (2 * wid + i) * 1024), 16, 0, 0); } }
__device__ __forceinline__ void rstd_consume_(int tid, PG8_LAS unsigned char* lds) {
    if (tid < BM) { const PG8_LAS f32x4* p = (const PG8_LAS f32x4*)(lds + RSP_OFF + tid * 64); const f32x4 a = p[0], b = p[1], c = p[2], d = p[3];
        const float s = (((a[0] + a[1]) + (a[2] + a[3])) + ((b[0] + b[1]) + (b[2] + b[3]))) + (((c[0] + c[1]) + (c[2] + c[3])) + ((d[0] + d[1]) + (d[2] + d[3])));
        ((PG8_LAS float*)(lds + RSTD_OFF))[tid] = __builtin_amdgcn_rsqf(s * (1.0f / 1024.0f) + NORM_EPS); }
    asm volatile("s_waitcnt lgkmcnt(0)" ::: "memory"); }
__device__ __forceinline__ u32x4 pack8(const f32x4& v0, const f32x4& v1) { u32x4 w; w.x = cvt_pk_bf16(v0[0], v0[1]); w.y = cvt_pk_bf16(v0[2], v0[3]); w.z = cvt_pk_bf16(v1[0], v1[1]); w.w = cvt_pk_bf16(v1[2], v1[3]); return w; }

template <int MODE> struct EpiProj {
    static constexpr bool PERM = true, AFTER_DRAIN = false;
    static constexpr bool RSTD = true; PG8_LAS float* rl;
    __device__ __forceinline__ void rstd_issue(const Unit& u, int wid, int lane, PG8_LAS unsigned char* lds) const { rstd_issue_(rowss, u, wid, lane, lds); }
    __device__ __forceinline__ void rstd_consume(int tid, PG8_LAS unsigned char* lds) const { rstd_consume_(tid, lds); }
    bf16_t* O; int ldc; const float* rowss; const float* gq; const float* gk; float qscale; int ncols;
    __device__ __forceinline__ void operator()(const f32x4 (&acc)[2][2][4][2], const Unit& u, int wr, int wc, int fr, int fq) const {
        const int row0 = u.pm * BM + wr * 64 + fr;
        if constexpr (MODE == 0) {
            const int col0 = u.pn * BM + wc * 32 + 8 * fq;
            if (gq != nullptr && u.pn >= 8 && u.pn < 12) {
                f32x4 g[2][2];
#pragma unroll
                for (int bj = 0; bj < 2; ++bj)
#pragma unroll
                    for (int n = 0; n < 2; ++n) g[bj][n] = *(const f32x4*)(gq + wc * 32 + 8 * fq + bj * HALF + 4 * n);
#pragma unroll
                for (int ai = 0; ai < 2; ++ai)
#pragma unroll
                    for (int m = 0; m < 4; ++m) { const int row = row0 + ai * HALF + m * 16; const float rs = rl[wr * 64 + fr + ai * HALF + m * 16]; bf16_t* rowp = O + (size_t)row * ldc + col0;
#pragma unroll
                        for (int bj = 0; bj < 2; ++bj) { f32x4 v[2];
#pragma unroll
                            for (int n = 0; n < 2; ++n) { const f32x4 y = acc[ai][bj][m][n] * rs; f32x4 e = y * (-1.4426950408889634f);
#pragma unroll
                                for (int i = 0; i < 4; ++i) e[i] = __builtin_amdgcn_rcpf(1.0f + __builtin_amdgcn_exp2f(e[i]));
                                v[n] = g[bj][n] * (y * e); }
                            *(u32x4*)(rowp + bj * HALF) = pack8(v[0], v[1]); } }
            } else {
#pragma unroll
            for (int ai = 0; ai < 2; ++ai)
#pragma unroll
                for (int m = 0; m < 4; ++m) { const int row = row0 + ai * HALF + m * 16; const float rs = rl[wr * 64 + fr + ai * HALF + m * 16]; bf16_t* rowp = O + (size_t)row * ldc + col0;
#pragma unroll
                    for (int bj = 0; bj < 2; ++bj) { const f32x4 v0 = acc[ai][bj][m][0] * rs, v1 = acc[ai][bj][m][1] * rs; if (col0 + bj * HALF < ncols) *(u32x4*)(rowp + bj * HALF) = pack8(v0, v1); } }
            }
        } else {
            const int which = u.pn >> 2;
            const int col0 = u.pn * BM + wc * 64 + 8 * fq;
            f32x4 g[2][2]; float post = 1.f;
#pragma unroll
            for (int bj = 0; bj < 2; ++bj)
#pragma unroll
                for (int n = 0; n < 2; ++n) g[bj][n] = (f32x4){1.f, 1.f, 1.f, 1.f};
            if (which < 2) { const float* gp = which == 0 ? gq : gk; post = which == 0 ? qscale : 1.f;
#pragma unroll
                for (int bj = 0; bj < 2; ++bj)
#pragma unroll
                    for (int n = 0; n < 2; ++n) g[bj][n] = *(const f32x4*)(gp + 32 * bj + 8 * fq + 4 * n); }
#pragma unroll
            for (int ai = 0; ai < 2; ++ai)
#pragma unroll
                for (int m = 0; m < 4; ++m) { const int row = row0 + ai * HALF + m * 16; const float rs = rl[wr * 64 + fr + ai * HALF + m * 16];
                    f32x4 y[2][2]; float ss = 0.f;
#pragma unroll
                    for (int bj = 0; bj < 2; ++bj)
#pragma unroll
                        for (int n = 0; n < 2; ++n) { y[bj][n] = acc[ai][bj][m][n] * rs; const f32x4 q = y[bj][n] * y[bj][n]; ss += (q[0] + q[1]) + (q[2] + q[3]); }
                    ss += __shfl_xor(ss, 16); ss += __shfl_xor(ss, 32);
                    float r = 1.f; if (which < 2) r = __builtin_amdgcn_rsqf(ss * (1.0f / 64.0f) + NORM_EPS) * post;
#pragma unroll
                    for (int bj = 0; bj < 2; ++bj) { const f32x4 v0 = y[bj][0] * r * g[bj][0], v1 = y[bj][1] * r * g[bj][1];
                        *(u32x4*)(O + (size_t)row * ldc + col0 + 32 * bj) = pack8(v0, v1); } }
        }
    }
};
struct EpiSwiGLU {
    static constexpr bool PERM = true, AFTER_DRAIN = false;
    bf16_t* H; int ldh; const float* rowss; PG8_LAS float* rl;
    static constexpr bool RSTD = true;
    __device__ __forceinline__ void rstd_issue(const Unit& u, int wid, int lane, PG8_LAS unsigned char* lds) const { rstd_issue_(rowss, u, wid, lane, lds); }
    __device__ __forceinline__ void rstd_consume(int tid, PG8_LAS unsigned char* lds) const { rstd_consume_(tid, lds); }
    __device__ __forceinline__ void operator()(const f32x4 (&acc)[2][2][4][2], const Unit& u, int wr, int wc, int fr, int fq) const {
        const int row0 = u.pm * BM + wr * 64 + fr, col0 = u.pn * HALF + wc * 32 + 8 * fq;
#pragma unroll
        for (int ai = 0; ai < 2; ++ai)
#pragma unroll
            for (int m = 0; m < 4; ++m) { const int row = row0 + ai * HALF + m * 16; const float rs = rl[wr * 64 + fr + ai * HALF + m * 16]; const float c1 = -rs * LOG2E_F, rs2 = rs * rs;
                const f32x4 t0 = acc[ai][0][m][0] * c1, t1 = acc[ai][0][m][1] * c1;
                f32x4 e0, e1;
                e0[0] = __builtin_amdgcn_exp2f(t0[0]); e0[1] = __builtin_amdgcn_exp2f(t0[1]); e0[2] = __builtin_amdgcn_exp2f(t0[2]); e0[3] = __builtin_amdgcn_exp2f(t0[3]);
                e1[0] = __builtin_amdgcn_exp2f(t1[0]); e1[1] = __builtin_amdgcn_exp2f(t1[1]); e1[2] = __builtin_amdgcn_exp2f(t1[2]); e1[3] = __builtin_amdgcn_exp2f(t1[3]);
                const f32x4 p0 = acc[ai][0][m][0] * acc[ai][1][m][0] * rs2, p1 = acc[ai][0][m][1] * acc[ai][1][m][1] * rs2;
                e0 = e0 + 1.0f; e1 = e1 + 1.0f;
                f32x4 r0, r1;
                r0[0] = __builtin_amdgcn_rcpf(e0[0]); r0[1] = __builtin_amdgcn_rcpf(e0[1]); r0[2] = __builtin_amdgcn_rcpf(e0[2]); r0[3] = __builtin_amdgcn_rcpf(e0[3]);
                r1[0] = __builtin_amdgcn_rcpf(e1[0]); r1[1] = __builtin_amdgcn_rcpf(e1[1]); r1[2] = __builtin_amdgcn_rcpf(e1[2]); r1[3] = __builtin_amdgcn_rcpf(e1[3]);
                *(u32x4*)(H + (size_t)row * ldh + col0) = pack8(p0 * r0, p1 * r1); }
    }
};
__device__ __forceinline__ f32x4 bf4lo(unsigned a, unsigned b) { return (f32x4){__uint_as_float(a << 16), __uint_as_float(a & 0xffff0000u), __uint_as_float(b << 16), __uint_as_float(b & 0xffff0000u)}; }
template <bool FINAL> struct EpiResid {
    static constexpr bool PERM = true, AFTER_DRAIN = false, RSTD = false;
    bf16_t* xb; float* out; float* rowss;
    __device__ __forceinline__ void operator()(const f32x4 (&acc)[2][2][4][2], const Unit& u, int wr, int wc, int fr, int fq) const {
        const int row0 = u.pm * BM + wr * 64 + fr, col0 = u.pn * BM + wc * 32 + 8 * fq;
#pragma unroll
        for (int ai = 0; ai < 2; ++ai) {
            u32x4 bv[4][2];
#pragma unroll
            for (int m = 0; m < 4; ++m)
#pragma unroll
                for (int bj = 0; bj < 2; ++bj) bv[m][bj] = *(const u32x4*)(xb + (size_t)(row0 + ai * HALF + m * 16) * 1024 + col0 + bj * HALF);
            asm volatile("" ::: "memory");
#pragma unroll
            for (int m = 0; m < 4; ++m) { const int row = row0 + ai * HALF + m * 16; const size_t off = (size_t)row * 1024 + col0; float ss = 0.f;
#pragma unroll
                for (int bj = 0; bj < 2; ++bj) { const u32x4 b = bv[m][bj];
                    const f32x4 v0 = bf4lo(b.x, b.y) + acc[ai][bj][m][0], v1 = bf4lo(b.z, b.w) + acc[ai][bj][m][1];
                    if constexpr (FINAL) { *(f32x4*)(out + off + bj * HALF) = v0; *(f32x4*)(out + off + bj * HALF + 4) = v1; }
                    else { *(u32x4*)(xb + off + bj * HALF) = pack8(v0, v1);
                        const f32x4 q0 = v0 * v0, q1 = v1 * v1; ss += ((q0[0] + q0[1]) + (q0[2] + q0[3])) + ((q1[0] + q1[1]) + (q1[2] + q1[3])); } }
                if constexpr (!FINAL) { ss += __shfl_xor(ss, 16); ss += __shfl_xor(ss, 32); if (fq == 0) rowss[(size_t)row * 16 + 4 * u.pn + wc] = ss; } }
            asm volatile("" ::: "memory");
        }
    }
};
template <class Epi, class Sched, bool ALIGN_EPI = false, bool SP2 = false>
__device__ __forceinline__ void gemm_phase(PG8_LAS unsigned char* lds, const Gemm g, const Sched& S, const Epi& E) {
    int tid_ = threadIdx.x; asm volatile("" : "+v"(tid_));
    const int tid = tid_, wid = __builtin_amdgcn_readfirstlane(tid >> 6), lane = tid & 63, wr = wid >> 2, wc = wid & 3, fr = lane & 15, fq = lane >> 4;
    const int K = g.K, nt = K / BK;
    unsigned voffA[2], voffB[2];
#pragma unroll
    for (int i = 0; i < 2; ++i) { int R, C; stage_rc(tid * 16 + i * 8192, R, C); const int Rb = Epi::PERM ? ((R & ~31) + perm32(R & 31)) : R;
        voffA[i] = (unsigned)(R * K + C) * 2u; voffB[i] = (unsigned)(Rb * K + C) * 2u; }
    const size_t kstep = (size_t)(BK * 2);
    const size_t hstep = (size_t)HALF * K * 2;
    const size_t tstep = 2 * hstep;
    const unsigned ldsb = (unsigned)(uintptr_t)lds;
    const unsigned ldsw = (unsigned)wid * 1024u;
    const int aoff = lds_byte(wr * 64 + fr, fq * 8), boff = lds_byte(wc * 32 + fr, fq * 8);
#define PG8_SA(b, h) (((b) * 2 + (h)) * HTB)
#define PG8_SB(b, h) ((4 + (b) * 2 + (h)) * HTB)
#define PG8_STAGE(bufoff, gbase, voff) do { _Pragma("unroll") for (int _i = 0; _i < 2; ++_i) { unsigned _sv; \
        asm volatile("s_mov_b32 %0, m0\n\ts_mov_b32 m0, %3\n\ts_nop 0\n\tglobal_load_lds_dwordx4 %1, %2\n\ts_mov_b32 m0, %0" : "=&s"(_sv) : "v"((voff)[_i]), "s"((const char*)(gbase)), "s"(ldsb + (unsigned)(bufoff) + ldsw + (unsigned)_i * 8192u) : "memory"); } } while (0)
#define PG8_LDA(dst, b, h) do { _Pragma("unroll") for (int m = 0; m < 4; ++m) _Pragma("unroll") for (int k = 0; k < 2; ++k) dst[m][k] = *(const PG8_LAS bf16x8*)(lds + PG8_SA(b, h) + aoff + m * 2048 + k * 1024); } while (0)
#define PG8_LDB(dst, b, h) do { _Pragma("unroll") for (int n = 0; n < 2; ++n) _Pragma("unroll") for (int k = 0; k < 2; ++k) dst[n][k] = *(const PG8_LAS bf16x8*)(lds + PG8_SB(b, h) + boff + n * 2048 + k * 1024); } while (0)
#define PG8_MMA(ai, bj, At, Bt) do { __builtin_amdgcn_s_setprio(1); _Pragma("unroll") for (int m = 0; m < 4; ++m) _Pragma("unroll") for (int n = 0; n < 2; ++n) _Pragma("unroll") for (int k = 0; k < 2; ++k) \
        acc[ai][bj][m][n] = __builtin_amdgcn_mfma_f32_16x16x32_bf16(Bt[n][k], At[m][k], acc[ai][bj][m][n], 0, 0, 0); __builtin_amdgcn_s_setprio(0); } while (0)
#define PG8_WAIT_V(n) asm volatile("s_waitcnt vmcnt(" #n ")" ::: "memory")
#define PG8_WAIT_L(n) asm volatile("s_waitcnt lgkmcnt(" #n ")" ::: "memory")
#define PG8_BAR __builtin_amdgcn_s_barrier()
#define PG8_SCHED __builtin_amdgcn_sched_barrier(0)
    Unit cur, nxt; int ui = 0;
    if (!S.next(0, cur)) return;
    f32x4 acc[2][2][4][2];
#pragma unroll
    for (int a = 0; a < 2; ++a)
#pragma unroll
        for (int b = 0; b < 2; ++b)
#pragma unroll
            for (int m = 0; m < 4; ++m)
#pragma unroll
                for (int n = 0; n < 2; ++n) acc[a][b][m][n] = (f32x4){0.f, 0.f, 0.f, 0.f};
    bf16x8 At[4][2], B0[2][2], B1[2][2];
    const char* cA = (const char*)g.A + (size_t)cur.pm * tstep; const char* cB = (const char*)g.Bt + (size_t)cur.pn * tstep;
    S.a_ready(cur);
    if constexpr (SP2) {
        PG8_STAGE(PG8_SB(0, 0), cB, voffB); PG8_STAGE(PG8_SB(0, 1), cB + hstep, voffB); PG8_STAGE(PG8_SA(0, 0), cA, voffA); PG8_STAGE(PG8_SA(0, 1), cA + hstep, voffA);
        if (wr == 1) PG8_BAR;
        PG8_WAIT_V(2); PG8_BAR;
        PG8_STAGE(PG8_SB(1, 0), cB + kstep, voffB); PG8_STAGE(PG8_SA(1, 0), cA + kstep, voffA); PG8_STAGE(PG8_SB(1, 1), cB + hstep + kstep, voffB);
        PG8_WAIT_V(6); PG8_BAR;
    } else {
        PG8_STAGE(PG8_SB(0, 0), cB, voffB); PG8_STAGE(PG8_SA(0, 0), cA, voffA); PG8_STAGE(PG8_SB(0, 1), cB + hstep, voffB); PG8_STAGE(PG8_SA(0, 1), cA + hstep, voffA);
        if (wr == 1) PG8_BAR;
        PG8_WAIT_V(4); PG8_BAR;
        PG8_STAGE(PG8_SB(1, 0), cB + kstep, voffB); PG8_STAGE(PG8_SA(1, 0), cA + kstep, voffA); PG8_STAGE(PG8_SB(1, 1), cB + hstep + kstep, voffB);
        PG8_WAIT_V(6); PG8_BAR;
    }
    for (;;) {
        const unsigned tok = S.request(tid);
        bool has_next = false; const char* nA = cA; const char* nB = cB;
        if constexpr (!Sched::DYNAMIC) { has_next = S.next(ui + 1, nxt);
            nA = has_next ? (const char*)g.A + (size_t)nxt.pm * tstep : cA; nB = has_next ? (const char*)g.Bt + (size_t)nxt.pn * tstep : cB; }
        for (int t = 0; t < nt; t += 2) {
            const bool last = (t == nt - 2);
            if constexpr (Epi::RSTD) { if (last) E.rstd_issue(cur, wid, lane, lds); }
            if constexpr (Sched::DYNAMIC) { if (t == nt - 4) S.resolve(tok, tid);
                if (last) { has_next = S.fetch(nxt); nA = has_next ? (const char*)g.A + (size_t)nxt.pm * tstep : cA; nB = has_next ? (const char*)g.Bt + (size_t)nxt.pn * tstep : cB; } }
            const char* a1 = cA + (size_t)(t + 1) * kstep;
            const char* a2 = last ? nA : cA + (size_t)(t + 2) * kstep; const char* b2 = last ? nB : cB + (size_t)(t + 2) * kstep;
            const char* a3 = a2 + kstep; const char* b3 = b2 + kstep;
            if (last && has_next) S.a_ready(nxt);
            if constexpr (SP2) {
            PG8_LDB(B0, 0, 0); PG8_LDB(B1, 0, 1); PG8_SCHED; PG8_LDA(At, 0, 0); PG8_STAGE(PG8_SA(1, 1), a1 + hstep, voffA);
            PG8_WAIT_V(8); PG8_WAIT_L(0); PG8_BAR; PG8_MMA(0, 0, At, B0); PG8_MMA(0, 1, At, B1); PG8_BAR; PG8_SCHED;
            PG8_LDA(At, 0, 1); PG8_STAGE(PG8_SB(0, 0), b2, voffB); PG8_STAGE(PG8_SB(0, 1), b2 + hstep, voffB); PG8_STAGE(PG8_SA(0, 0), a2, voffA);
            PG8_WAIT_V(8); PG8_WAIT_L(0); PG8_BAR; PG8_MMA(1, 0, At, B0); PG8_MMA(1, 1, At, B1); PG8_BAR; PG8_SCHED;
            PG8_LDB(B0, 1, 0); PG8_LDB(B1, 1, 1); PG8_SCHED; PG8_LDA(At, 1, 0); PG8_STAGE(PG8_SA(0, 1), a2 + hstep, voffA);
            PG8_WAIT_V(8); PG8_WAIT_L(0); PG8_BAR; PG8_MMA(0, 0, At, B0); PG8_MMA(0, 1, At, B1); PG8_BAR; PG8_SCHED;
            PG8_LDA(At, 1, 1); PG8_STAGE(PG8_SB(1, 0), b3, voffB); PG8_STAGE(PG8_SB(1, 1), b3 + hstep, voffB); PG8_STAGE(PG8_SA(1, 0), a3, voffA);
            PG8_WAIT_V(8); PG8_WAIT_L(0); PG8_BAR;
            if constexpr (Epi::RSTD) { if (last) E.rstd_consume(tid, lds); }
            PG8_MMA(1, 0, At, B0); PG8_MMA(1, 1, At, B1); PG8_BAR; PG8_SCHED;
            } else {
            PG8_LDB(B0, 0, 0); PG8_SCHED; PG8_LDA(At, 0, 0); PG8_STAGE(PG8_SA(1, 1), a1 + hstep, voffA);
            PG8_WAIT_L(8); PG8_BAR; PG8_WAIT_L(0); PG8_MMA(0, 0, At, B0); PG8_BAR; PG8_SCHED;
            PG8_LDB(B1, 0, 1); PG8_STAGE(PG8_SB(0, 0), b2, voffB);
            PG8_BAR; PG8_WAIT_L(0); PG8_MMA(0, 1, At, B1); PG8_BAR;
            PG8_LDA(At, 0, 1); PG8_STAGE(PG8_SA(0, 0), a2, voffA);
            PG8_BAR; PG8_WAIT_L(0); PG8_MMA(1, 0, At, B0); PG8_BAR; PG8_SCHED;
            PG8_STAGE(PG8_SB(0, 1), b2 + hstep, voffB);
            PG8_WAIT_V(6); PG8_BAR; PG8_MMA(1, 1, At, B1); PG8_BAR;
            PG8_LDB(B0, 1, 0); PG8_SCHED; PG8_LDA(At, 1, 0); PG8_STAGE(PG8_SA(0, 1), a2 + hstep, voffA);
            PG8_WAIT_L(8); PG8_BAR; PG8_WAIT_L(0); PG8_MMA(0, 0, At, B0); PG8_BAR; PG8_SCHED;
            PG8_LDB(B1, 1, 1); PG8_STAGE(PG8_SB(1, 0), b3, voffB);
            PG8_BAR; PG8_WAIT_L(0); PG8_MMA(0, 1, At, B1); PG8_BAR;
            PG8_LDA(At, 1, 1); PG8_STAGE(PG8_SA(1, 0), a3, voffA);
            PG8_BAR; PG8_WAIT_L(0); PG8_MMA(1, 0, At, B0); PG8_BAR; PG8_SCHED;
            PG8_STAGE(PG8_SB(1, 1), b3 + hstep, voffB);
            PG8_WAIT_V(6); PG8_BAR; PG8_MMA(1, 1, At, B1); PG8_BAR;
            }
        }
        if constexpr (ALIGN_EPI) { if (wr == 0) PG8_BAR; }
        if constexpr (!Epi::AFTER_DRAIN) { E(acc, cur, wr, wc, fr, fq); S.done(cur); }
        if (!has_next) break;
#pragma unroll
        for (int a = 0; a < 2; ++a)
#pragma unroll
            for (int b = 0; b < 2; ++b)
#pragma unroll
                for (int m = 0; m < 4; ++m)
#pragma unroll
                    for (int n = 0; n < 2; ++n) acc[a][b][m][n] = (f32x4){0.f, 0.f, 0.f, 0.f};
        cur = nxt; cA = nA; cB = nB; ++ui;
        if constexpr (ALIGN_EPI) { if (wr == 1) PG8_BAR; }
    }
    PG8_WAIT_V(0);
    if constexpr (!ALIGN_EPI) { if (wr == 0) PG8_BAR; }
    PG8_BAR;
    if constexpr (Epi::AFTER_DRAIN) { E.fused(acc, cur, wr, wc, fr, fq, lds, wid, lane); S.done(cur); }
#undef PG8_SA
#undef PG8_SB
#undef PG8_STAGE
#undef PG8_LDA
#undef PG8_LDB
#undef PG8_MMA
#undef PG8_WAIT_V
#undef PG8_WAIT_L
#undef PG8_BAR
#undef PG8_SCHED
}
}
#define GAS __attribute__((address_space(1)))
#define LAS __attribute__((address_space(3)))
typedef unsigned short bf16;
typedef unsigned v4u __attribute__((ext_vector_type(4)));
typedef float f32x4 __attribute__((ext_vector_type(4)));
typedef short bf16x8 __attribute__((ext_vector_type(8)));
typedef GAS unsigned gu32;
typedef GAS unsigned long long gu64;
#define RLX_AGENT __ATOMIC_RELAXED, __HIP_MEMORY_SCOPE_AGENT
#define LDS_WAIT() asm volatile("s_waitcnt lgkmcnt(0)" ::: "memory")
#define VM_WAIT() asm volatile("s_waitcnt vmcnt(0)" ::: "memory")
__device__ __forceinline__ unsigned long long rt() { return __builtin_amdgcn_s_memrealtime(); }
__device__ __forceinline__ unsigned f2bf(float f) { unsigned u = __builtin_bit_cast(unsigned, f); return (u + 0x7fffu + ((u >> 16) & 1u)) >> 16; }
__device__ __forceinline__ unsigned pk2(float lo, float hi) { return f2bf(lo) | (f2bf(hi) << 16); }

#define XB_TMO      128
#define XB_XCNT(j)  (256  + 64 * (j))
#define XB_XSUB(j)  (1280 + 64 * (j))
#define XB_XGEN(j)  (2304 + 64 * (j))
#define XB_TOP      3328
#define XB_TOPGEN   3392
#define XCD_BAR_WORDS 3456
#define XB_SPIN_CAP (1u << 18)

__device__ __forceinline__ unsigned xb_ld(unsigned* p)              { return __hip_atomic_load(p, __ATOMIC_RELAXED, __HIP_MEMORY_SCOPE_AGENT); }
__device__ __forceinline__ unsigned xb_add(unsigned* p, unsigned v) { return __hip_atomic_fetch_add(p, v, __ATOMIC_RELAXED, __HIP_MEMORY_SCOPE_AGENT); }
__device__ __forceinline__ unsigned xb_xcc_id() { return (unsigned)__builtin_amdgcn_s_getreg((3 << 11) | 20) & 0xFu; }
#define XB_SPIN(cond, bar) do { unsigned _sp = 0; while (cond) { __builtin_amdgcn_s_sleep(1); \
    if ((++_sp & 255u) == 0u) { if (xb_ld(&(bar)[XB_TMO])) break; if (_sp > XB_SPIN_CAP) { atomicAdd(&(bar)[XB_TMO], 1u); break; } } } } while (0)

struct XcdBarrier {
    unsigned* bar; unsigned x;
    volatile LAS unsigned* st;
};

__device__ __forceinline__ XcdBarrier xcd_barrier_post(unsigned* bar, volatile LAS unsigned* st) {
    XcdBarrier b; b.bar = bar; b.x = xb_xcc_id(); b.st = st;
    if (threadIdx.x == 0) (void)xb_add(&bar[XB_XCNT(b.x)], 1u);
    return b;
}
__device__ __forceinline__ void xcd_barrier_complete(unsigned* bar, unsigned x, unsigned& nloc, unsigned& nx) {
    const unsigned G = gridDim.x * gridDim.y * gridDim.z;
    unsigned sum, cnt, mine, sp = 0u;
    for (;;) {
        sum = 0u; cnt = 0u; mine = 0u;
#pragma unroll
        for (unsigned j = 0; j < 16; ++j) { const unsigned c = xb_ld(&bar[XB_XCNT(j)]); sum += c; cnt += (c > 0u) ? 1u : 0u; mine = (j == x) ? c : mine; }
        if (sum == G) break;
        __builtin_amdgcn_s_sleep(1);
        if ((++sp & 255u) == 0u) { if (xb_ld(&bar[XB_TMO])) break; if (sp > XB_SPIN_CAP) { atomicAdd(&bar[XB_TMO], 1u); break; } }
    }
    nloc = mine > 0u ? mine : 1u; nx = cnt > 0u ? cnt : 1u;
}

__device__ __forceinline__ void xcd_barrier(const XcdBarrier& b) {
    asm volatile("s_waitcnt vmcnt(0)" ::: "memory");
    __syncthreads();
    if (threadIdx.x == 0) {
        unsigned* bar = b.bar;
        __builtin_amdgcn_s_waitcnt(0);
        unsigned nloc = b.st[0], nx = b.st[1];
        if (nloc == 0u) { xcd_barrier_complete(bar, b.x, nloc, nx); b.st[0] = nloc; b.st[1] = nx; }
        const unsigned old = xb_add(&bar[XB_XSUB(b.x)], 1u);
        const unsigned gen = old / nloc;
        if (old + 1u == (gen + 1u) * nloc) {
            __builtin_amdgcn_fence(__ATOMIC_RELEASE, "agent");
            asm volatile("s_waitcnt vmcnt(0)" ::: "memory");
            const unsigned og = xb_add(&bar[XB_TOP], 1u);
            const unsigned tg = og / nx;
            if (og + 1u == (tg + 1u) * nx) xb_add(&bar[XB_TOPGEN], 1u);
            else XB_SPIN(xb_ld(&bar[XB_TOPGEN]) == tg, bar);
            __builtin_amdgcn_fence(__ATOMIC_ACQUIRE, "agent");
            xb_add(&bar[XB_XGEN(b.x)], 1u);
            asm volatile("s_waitcnt vmcnt(0)" ::: "memory");
        } else {
            XB_SPIN(xb_ld(&bar[XB_XGEN(b.x)]) == gen, bar);
            __builtin_amdgcn_fence(__ATOMIC_ACQUIRE, "agent");
            asm volatile("s_waitcnt vmcnt(0)" ::: "memory");
        }
    }
    __syncthreads();
}

constexpr int BATCH = 32, SEQ = 2048, DM = 1024, M = BATCH * SEQ;
constexpr int GLA_H = 4, GLA_HK = 128, GLA_HV = 256, GLA_RANK = 16, GLA_CHUNK = 64, GLA_IN = 3088, GLA_NP = 3328;
constexpr int SB_N = 3072;
constexpr int DFF = 2816;
constexpr float EPS = 1e-6f, LOG2E = 1.4426950408889634f;
constexpr int NWAVES = 8;

#ifndef GLA_HANDOFF
#define GLA_HANDOFF 0
#endif
constexpr size_t MiB = 1u << 20;
constexpr size_t WS_CTL = 0, CTL_ZERO_BYTES = 1 * MiB;
constexpr size_t WS_GLA_WIN = 2 * MiB;
constexpr size_t WS_GLA_WOUT = 16 * MiB;
constexpr size_t WS_SB_WIN = 20 * MiB;
constexpr size_t WS_SB_WOUT = 32 * MiB;
constexpr size_t WS_WGU = 36 * MiB;
constexpr size_t WS_WD = 80 * MiB;
constexpr size_t WS_ROWSS = 104 * MiB;
constexpr size_t WS_XB = 108 * MiB;
constexpr size_t WS_OG = 236 * MiB;
constexpr size_t WS_PROJ = 364 * MiB;
constexpr size_t WS_END = 780 * MiB;
constexpr int CW_BAR = 4096;
constexpr int CW_DYN = 16384;
constexpr int CW_RDY = 65536;
constexpr int CW_RDY_TMO = CW_RDY + 2 * 16384;

constexpr int RING_BYTES = 131072;
constexpr int LDSCTL_OFF = RING_BYTES, MISC_OFF = LDSCTL_OFF + 320;
constexpr int LDS_BYTES = 163840;

__device__ __forceinline__ float wave_sum(float v) {
#pragma unroll
    for (int o = 1; o < 64; o <<= 1) v += __shfl_xor(v, o);
    return v;
}
__device__ __forceinline__ unsigned cvtpk(float lo, float hi) { unsigned r; asm("v_cvt_pk_bf16_f32 %0, %1, %2" : "=v"(r) : "v"(lo), "v"(hi)); return r; }
__device__ __forceinline__ float bf2f(unsigned short b) { return __uint_as_float(((unsigned)b) << 16); }
__device__ __forceinline__ void glds16(const void* g, unsigned lds_base) {
    unsigned sv; asm volatile("s_mov_b32 %0, m0\n\ts_mov_b32 m0, %2\n\ts_nop 0\n\tglobal_load_lds_dwordx4 %1, off\n\ts_mov_b32 m0, %0" : "=&s"(sv) : "v"(g), "s"(lds_base) : "memory"); }
typedef short s16x4 __attribute__((ext_vector_type(4)));
typedef float f32x16 __attribute__((ext_vector_type(16)));
typedef unsigned u32x2 __attribute__((ext_vector_type(2)));
typedef LAS const char* lds_cptr;
__device__ __forceinline__ s16x4 vtr(lds_cptr p) { return __builtin_bit_cast(s16x4, __builtin_amdgcn_ds_read_tr16_b64_v4i16((LAS s16x4*)p)); }
__device__ __forceinline__ bf16x8 cat8(s16x4 a, s16x4 b) { return (bf16x8){a[0], a[1], a[2], a[3], b[0], b[1], b[2], b[3]}; }
__device__ __forceinline__ int crow(int r, int hi) { return (r & 3) + 8 * (r >> 2) + 4 * hi; }
#define MFMA32(a, b, c) __builtin_amdgcn_mfma_f32_32x32x16_bf16((a), (b), (c), 0, 0, 0)
#define WG_BAR() asm volatile("s_waitcnt vmcnt(0) lgkmcnt(0)\n\ts_barrier" ::: "memory")
__device__ __forceinline__ bf16x8 pk8(const f32x16& x, int s) {
    v4u p; p.x = cvtpk(x[8 * s], x[8 * s + 1]); p.y = cvtpk(x[8 * s + 2], x[8 * s + 3]); p.z = cvtpk(x[8 * s + 4], x[8 * s + 5]); p.w = cvtpk(x[8 * s + 6], x[8 * s + 7]);
    return __builtin_bit_cast(bf16x8, p); }

__device__ __forceinline__ void wt_item(const float* W, int ldw, int c0, int nvalid, const float* g, bf16* WT, int K, int n0, int k0, LAS float* scr, int lane) {
    const int n = lane & 31;
#pragma unroll
    for (int hb = 0; hb < 2; ++hb) { float v[16];
#pragma unroll
        for (int i = 0; i < 16; ++i) { const int kk = 2 * (16 * hb + i) + (lane >> 5); v[i] = 0.f; if (n < nvalid) v[i] = W[(size_t)(k0 + kk) * ldw + c0 + n]; }
#pragma unroll
        for (int i = 0; i < 16; ++i) { const int kk = 2 * (16 * hb + i) + (lane >> 5); float t = v[i]; if (g) t *= g[k0 + kk]; scr[kk * 33 + n] = t; } }
    LDS_WAIT(); asm volatile("" ::: "memory");
    const int c = lane & 7;
#pragma unroll
    for (int j = 0; j < 4; ++j) { const int nn = (lane >> 3) + 8 * j; const LAS float* s = scr + (8 * c) * 33 + nn;
        v4u o; o.x = pk2(s[0 * 33], s[1 * 33]); o.y = pk2(s[2 * 33], s[3 * 33]); o.z = pk2(s[4 * 33], s[5 * 33]); o.w = pk2(s[6 * 33], s[7 * 33]);
        *(v4u*)(WT + (size_t)(n0 + nn) * K + k0 + 8 * c) = o; }
    LDS_WAIT(); asm volatile("" ::: "memory");
}
struct Ptrs {
    const float *x, *attn_g, *ffn_g, *gla_win, *gla_w2, *gla_b, *gla_ng, *gla_wout, *sb_win, *sb_qg, *sb_kg, *sb_wout, *wgu, *wd;
    float* out; unsigned char* ws;
};
__device__ __forceinline__ void wt_convert(const Ptrs& P, LAS unsigned char* lds, int gw, int NGW, int wave, int lane, int stage) {
    LAS float* scr = (LAS float*)(lds + wave * 16384);
    constexpr int I_GW = 16 * (GLA_NP / 32), I_O = 16 * 32, I_SW = 16 * (SB_N / 32), I_GU = 16 * (2 * DFF / 32), I_D = (DFF / 64) * 32;
    constexpr int NITEMS = 2 * I_GW + 2 * I_O + 2 * I_SW + 2 * I_O + 4 * I_GU + 4 * I_D;
    for (int it = gw; it < NITEMS; it += NGW) {
        int r = it;
        { int st; if (r < I_GW) st = 0; else if (r < 2 * I_GW + 2 * I_O) st = (GLA_HANDOFF && r >= 2 * I_GW && r < 2 * I_GW + I_O) ? 0 : 1  ; else { int q = r - (2 * I_GW + 2 * I_O);
            if (q < 2 * I_SW) st = q < I_SW ? 1 : 2; else { q -= 2 * I_SW; if (q < 2 * I_O) st = q < I_O ? 1 : 2; else { q -= 2 * I_O; if (q < 4 * I_GU) st = q < 3 * I_GU ? 1 : 2; else { q -= 4 * I_GU; st = q < 3 * I_D ? 1 : 2; } } } }
          if (st != stage) continue; }
        if (r < 2 * I_GW) { const int j = r / I_GW; r -= j * I_GW; const int nblk = GLA_NP / 32, kb = r / nblk, nb = r % nblk, n0 = 32 * nb; int nv = GLA_IN - n0; nv = nv < 0 ? 0 : (nv > 32 ? 32 : nv);
            wt_item(P.gla_win + (size_t)j * DM * GLA_IN, GLA_IN, n0, nv, P.attn_g + (2 * j) * DM, (bf16*)(P.ws + WS_GLA_WIN + (size_t)j * 7 * MiB), DM, n0, 64 * kb, scr, lane); continue; } r -= 2 * I_GW;
        if (r < 2 * I_O) { const int j = r / I_O; r -= j * I_O; const int kb = r / 32, nb = r % 32;
            wt_item(P.gla_wout + (size_t)j * DM * DM, DM, 32 * nb, 32, nullptr, (bf16*)(P.ws + WS_GLA_WOUT + (size_t)j * 2 * MiB), DM, 32 * nb, 64 * kb, scr, lane); continue; } r -= 2 * I_O;
        if (r < 2 * I_SW) { const int j = r / I_SW; r -= j * I_SW; const int nblk = SB_N / 32, kb = r / nblk, nb = r % nblk, n0 = 32 * nb;
            const int pn = n0 >> 8, p = n0 & 255, bj = p >> 7, wc = (p & 127) >> 5, c0 = 256 * pn + 64 * wc + 32 * bj;
            wt_item(P.sb_win + (size_t)j * DM * SB_N, SB_N, c0, 32, P.attn_g + (2 * j + 1) * DM, (bf16*)(P.ws + WS_SB_WIN + (size_t)j * 6 * MiB), DM, n0, 64 * kb, scr, lane); continue; } r -= 2 * I_SW;
        if (r < 2 * I_O) { const int j = r / I_O; r -= j * I_O; const int kb = r / 32, nb = r % 32;
            wt_item(P.sb_wout + (size_t)j * DM * DM, DM, 32 * nb, 32, nullptr, (bf16*)(P.ws + WS_SB_WOUT + (size_t)j * 2 * MiB), DM, 32 * nb, 64 * kb, scr, lane); continue; } r -= 2 * I_O;
        if (r < 4 * I_GU) { const int i = r / I_GU; r -= i * I_GU; const int nblk = 2 * DFF / 32, kb = r / nblk, nb = r % nblk, n0 = 32 * nb;
            const int pn = n0 >> 8, p = n0 & 255, bj = p >> 7, y = p & 127, c0 = bj * DFF + 128 * pn + y;
            wt_item(P.wgu + (size_t)i * DM * 2 * DFF, 2 * DFF, c0, 32, P.ffn_g + i * DM, (bf16*)(P.ws + WS_WGU + (size_t)i * 11 * MiB), DM, n0, 64 * kb, scr, lane); continue; } r -= 4 * I_GU;
        { const int i = r / I_D; r -= i * I_D; const int kb = r / 32, nb = r % 32;
            wt_item(P.wd + (size_t)i * DFF * DM, DM, 32 * nb, 32, nullptr, (bf16*)(P.ws + WS_WD + (size_t)i * 6 * MiB), DFF, 32 * nb, 64 * kb, scr, lane); }
    }
}
__device__ __forceinline__ void p0_prologue(const Ptrs& P, LAS unsigned char* lds, int vcu, int G, int wave, int lane) {
    const int gw = vcu * NWAVES + wave, NGW = G * NWAVES;
    wt_convert(P, lds, gw, NGW, wave, lane, 0);
    bf16* xb = (bf16*)(P.ws + WS_XB); float* rowss = (float*)(P.ws + WS_ROWSS);
    for (int m = gw; m < M; m += NGW) {
        const f32x4* xr = (const f32x4*)(P.x + (size_t)m * DM) + lane; f32x4 v[4]; float s = 0.f;
#pragma unroll
        for (int j = 0; j < 4; ++j) { v[j] = xr[64 * j]; s += (v[j][0] * v[j][0] + v[j][1] * v[j][1]) + (v[j][2] * v[j][2] + v[j][3] * v[j][3]); }
        s = wave_sum(s);
        u32x2* o8 = (u32x2*)(xb + (size_t)m * DM) + lane;
#pragma unroll
        for (int j = 0; j < 4; ++j) { u32x2 w; w.x = cvtpk(v[j][0], v[j][1]); w.y = cvtpk(v[j][2], v[j][3]); o8[64 * j] = w; }
        if (lane < 16) rowss[(size_t)m * 16 + lane] = lane == 0 ? s : 0.f;
    }
}

namespace sbp {
constexpr int SLOTB = 8192, NSLOT = 5, LDS_K = 0, LDS_V = NSLOT * SLOTB, LDS_OST = 2 * NSLOT * SLOTB, LDS_FLAG = LDS_OST + 8 * 4096, LDS_END = LDS_FLAG + 64;
static_assert(LDS_END <= RING_BYTES, "SB LDS map");
template <bool EARLY>
__device__ __forceinline__ void sb_unit(int b, int h, int qb, const bf16* QKV, bf16* O, LAS unsigned char* lds) {
    int tid_ = threadIdx.x; asm volatile("" : "+v"(tid_));
    const int tid = tid_, lane = tid & 63, r32 = lane & 31, hi = lane >> 5; const int wid = __builtin_amdgcn_readfirstlane(tid >> 6);
    const long rowbase = (long)b * SEQ; const int q0 = qb * 256, jb0 = 4 * qb;
    const bf16* Qw = QKV + (rowbase + q0 + wid * 32) * SB_N + h * 64;
    const bf16* Kb = QKV + rowbase * SB_N + 1024 + h * 64; const bf16* Vb = Kb + 1024;
    const unsigned lds0 = (unsigned)(uintptr_t)lds;
    const bf16* ksrc = Kb + (long)lane * SB_N + wid * 8;
    const bf16* vsrc = Vb + (long)(16 * (wid & 3) + (lane >> 2)) * SB_N + (wid >> 2) * 32 + (lane & 3) * 8;
    const unsigned kdst = lds0 + LDS_K + wid * 1024, vdst = lds0 + LDS_V + wid * 1024;
#define SB_DMA(j) do { const int sl_ = (j) % NSLOT; glds16(ksrc + (long)(j) * 64 * SB_N, (unsigned)__builtin_amdgcn_readfirstlane(kdst + sl_ * SLOTB)); \
                       glds16(vsrc + (long)(j) * 64 * SB_N, (unsigned)__builtin_amdgcn_readfirstlane(vdst + sl_ * SLOTB)); } while (0)
    LAS unsigned* flags = (LAS unsigned*)(lds + LDS_FLAG);
    if (lane == 0) flags[wid] = 0u;
    SB_DMA(jb0); SB_DMA(jb0 + 1); SB_DMA(jb0 + 2); SB_DMA(jb0 + 3);
    const unsigned qoff = (unsigned)(LDS_OST + wid * 4096);
#pragma unroll
    for (int d0_ = 0; d0_ < 4; ++d0_) glds16(Qw + (long)r32 * SB_N + d0_ * 16 + hi * 8, (unsigned)__builtin_amdgcn_readfirstlane(lds0 + qoff + d0_ * 1024));
    WG_BAR();
    bf16x8 qr[4];
#pragma unroll
    for (int d0 = 0; d0 < 4; ++d0) qr[d0] = *(LAS const bf16x8*)(lds + qoff + d0 * 1024 + lane * 16);
    f32x16 o0, o1;
#pragma unroll
    for (int r = 0; r < 16; ++r) { o0[r] = 0.f; o1[r] = 0.f; }
    float prun = 1.f;
    const int qw0 = q0 + wid * 32, tq = qw0 + r32, jd = jb0 + (wid >> 1);
    bool wdone = false;
    const int NS = jb0 + 4;
    for (int t = 0; t < NS; ++t) {
        const int par = t & 1;
        WG_BAR();
        { const v4u f0 = *(LAS v4u*)(flags + 8 * par), f1 = *(LAS v4u*)(flags + 8 * par + 4);
          if ((f0.x & f0.y & f0.z & f0.w & f1.x & f1.y & f1.z & f1.w) != 0u) break; }
        if (jb0 - t - 1 >= 0) SB_DMA(jb0 - t - 1);
        const int j = jd - t;
        if (!wdone && j >= 0) {
            const int slot = j % NSLOT, k0 = 64 * j;
            lds_cptr kp = (lds_cptr)lds + LDS_K + slot * SLOTB + hi * 1024 + r32 * 16;
            f32x16 p0, p1;
#pragma unroll
            for (int r = 0; r < 16; ++r) { p0[r] = 0.f; p1[r] = 0.f; }
#pragma unroll
            for (int d0 = 0; d0 < 4; ++d0) { const bf16x8 ka = *(LAS const bf16x8*)(kp + d0 * 2048), kb = *(LAS const bf16x8*)(kp + d0 * 2048 + 512);
                p0 = MFMA32(ka, qr[d0], p0); p1 = MFMA32(kb, qr[d0], p1); }
#pragma unroll
            for (int r = 0; r < 16; ++r) {
                float fa = __builtin_amdgcn_rcpf(1.0f + __builtin_amdgcn_exp2f(p0[r])), fb = __builtin_amdgcn_rcpf(1.0f + __builtin_amdgcn_exp2f(p1[r]));
                if (t == 0) { const int key = k0 + crow(r, hi); if (key >= tq) fa = 1.f; if (key + 32 >= tq) fb = 1.f; }
                p0[r] = fa; p1[r] = fb; }
            float pt[8], pp[8];
#pragma unroll
            for (int g = 0; g < 8; ++g) { const float gpv = g < 4 ? (p0[4 * g] * p0[4 * g + 1]) * (p0[4 * g + 2] * p0[4 * g + 3]) : (p1[4 * g - 16] * p1[4 * g - 15]) * (p1[4 * g - 14] * p1[4 * g - 13]);
                auto rr = __builtin_amdgcn_permlane32_swap(__float_as_uint(gpv), __float_as_uint(gpv), false, false);
                const float a = __uint_as_float(rr[0]), c = __uint_as_float(rr[1]); pp[g] = a * c; pt[g] = hi ? 1.0f : c; }
            float Y = prun, X[8];
#pragma unroll
            for (int g = 7; g >= 0; --g) { X[g] = Y * pt[g]; Y = Y * pp[g]; }
            prun = Y;
#pragma unroll
            for (int g = 0; g < 4; ++g) {
                float E = X[g];
#pragma unroll
                for (int i = 3; i >= 0; --i) { const float tt = E * p0[4 * g + i]; p0[4 * g + i] = E - tt; E = tt; }
                E = X[4 + g];
#pragma unroll
                for (int i = 3; i >= 0; --i) { const float tt = E * p1[4 * g + i]; p1[4 * g + i] = E - tt; E = tt; }
            }
            if (EARLY) wdone = __all(prun == 0.0f) != 0;
            const bf16x8 pw0 = pk8(p0, 0), pw1 = pk8(p0, 1), pw2 = pk8(p1, 0), pw3 = pk8(p1, 1);
            lds_cptr vp = (lds_cptr)lds + LDS_V + slot * SLOTB + ((lane >> 4) & 1) * 32 + (lane & 3) * 8 + (4 * hi + ((lane & 15) >> 2)) * 64;
#define SB_VF(dh, s) cat8(vtr(vp + (dh) * 4096 + (s) * 1024), vtr(vp + (dh) * 4096 + (s) * 1024 + 512))
            o0 = MFMA32(pw0, SB_VF(0, 0), o0); o1 = MFMA32(pw0, SB_VF(1, 0), o1);
            o0 = MFMA32(pw1, SB_VF(0, 1), o0); o1 = MFMA32(pw1, SB_VF(1, 1), o1);
            o0 = MFMA32(pw2, SB_VF(0, 2), o0); o1 = MFMA32(pw2, SB_VF(1, 2), o1);
            o0 = MFMA32(pw3, SB_VF(0, 3), o0); o1 = MFMA32(pw3, SB_VF(1, 3), o1);
#undef SB_VF
        }
        if (lane == 0) flags[8 * (par ^ 1) + wid] = (wdone || j <= 0) ? 1u : 0u;
    }
    bf16* Ow = O + (rowbase + q0 + wid * 32) * DM + h * 64; LAS bf16* stg = (LAS bf16*)(lds + LDS_OST) + wid * 2048;
#pragma unroll
    for (int r = 0; r < 16; ++r) { const int orow = crow(r, hi); stg[orow * 64 + r32] = (bf16)f2bf(o0[r]); stg[orow * 64 + 32 + r32] = (bf16)f2bf(o1[r]); }
    LDS_WAIT();
#pragma unroll
    for (int i = 0; i < 4; ++i) { const int row = i * 8 + (lane >> 3), ch = lane & 7; *(v4u*)(Ow + (long)row * DM + ch * 8) = *(LAS const v4u*)(stg + row * 64 + ch * 8); }
    WG_BAR();
#undef SB_DMA
}
}

namespace glp {
constexpr int PQ = 272, PT = 144;
constexpr int L_QI = 0, L_KI = L_QI + 64 * PQ, L_KT = L_KI + 64 * PQ, L_VI = 53248, L_QR = L_VI + 32768, L_KR = L_QR + 16384, L_GLR = L_KR + 16384, L_DEC = L_GLR + 2048, L_SS = L_DEC + 512, L_GN = L_SS + 4096, L_END = L_GN + 1024;
static_assert(L_KT + 128 * PT <= L_VI && L_END + 4096 <= RING_BYTES && RING_BYTES + 1024 + 7 * 4096 <= LDS_BYTES, "GLA LDS map");
__device__ __forceinline__ int permk(int k) { const int x = k & 15; return (k & ~15) | (x & 3) | (((x >> 3) & 1) << 2) | (((x >> 2) & 1) << 3); }
__device__ __forceinline__ void gla_seq(int b, int h, const bf16* proj, const float* w2, const float* bg, const float* gnorm, bf16* og, unsigned* rdy, LAS unsigned char* lds) {
    const int wid = __builtin_amdgcn_readfirstlane(threadIdx.x >> 6);
    const unsigned lds0 = (unsigned)(uintptr_t)lds;
    bf16x8 w2f; float bgv;
    { int lane0 = threadIdx.x & 63; asm volatile("" : "+v"(lane0)); const int kcol = h * 128 + 16 * wid + (lane0 & 15), j0 = 8 * ((lane0 >> 4) & 1);
      v4u p; p.x = pk2(w2[(j0 + 0) * 512 + kcol], w2[(j0 + 1) * 512 + kcol]); p.y = pk2(w2[(j0 + 2) * 512 + kcol], w2[(j0 + 3) * 512 + kcol]);
      p.z = pk2(w2[(j0 + 4) * 512 + kcol], w2[(j0 + 5) * 512 + kcol]); p.w = pk2(w2[(j0 + 6) * 512 + kcol], w2[(j0 + 7) * 512 + kcol]); if (lane0 >= 32) { p.x = 0u; p.y = 0u; p.z = 0u; p.w = 0u; } w2f = __builtin_bit_cast(bf16x8, p); bgv = bg[kcol]; }
    { int tid0 = threadIdx.x; asm volatile("" : "+v"(tid0)); if (tid0 < 256) ((LAS float*)(lds + L_GN))[tid0] = gnorm[tid0]; }
    f32x16 S[4];
#pragma unroll
    for (int kt = 0; kt < 4; ++kt)
#pragma unroll
        for (int r = 0; r < 16; ++r) S[kt][r] = 0.f;
    f32x16 OT0, OT1;
#pragma unroll
    for (int r = 0; r < 16; ++r) { OT0[r] = 0.f; OT1[r] = 0.f; }
    const float qscale = 0.08838834764831845f;
    constexpr int NCH = SEQ / GLA_CHUNK;
    const long tokb = (long)b * SEQ;
#define GLA_REQ_QKG(cc, lane_) do { const long t0_ = tokb + (long)(cc) * GLA_CHUNK; \
        _Pragma("unroll") for (int i_ = 0; i_ < 2; ++i_) { const bf16* src_ = proj + (t0_ + 8 * wid + 4 * i_ + ((lane_) >> 4)) * GLA_NP + h * 128 + 8 * ((lane_) & 15); \
            glds16(src_, (unsigned)__builtin_amdgcn_readfirstlane(lds0 + L_QR + (8 * wid + 4 * i_) * 256)); glds16(src_ + 512, (unsigned)__builtin_amdgcn_readfirstlane(lds0 + L_KR + (8 * wid + 4 * i_) * 256)); } \
        if (wid < 2) glds16(proj + (t0_ + 32 * wid + ((lane_) >> 1)) * GLA_NP + 3072 + 8 * ((lane_) & 1), (unsigned)__builtin_amdgcn_readfirstlane(lds0 + L_GLR + wid * 1024)); } while (0)
#define GLA_REQ_V(cc, lane_) do { const long t0_ = tokb + (long)(cc) * GLA_CHUNK; \
        _Pragma("unroll") for (int tb_ = 0; tb_ < 4; ++tb_) glds16(proj + (t0_ + 16 * tb_ + ((lane_) >> 2)) * GLA_NP + 1024 + h * 256 + 32 * wid + 8 * ((lane_) & 3), (unsigned)__builtin_amdgcn_readfirstlane(lds0 + L_VI + wid * 4096 + tb_ * 1024)); } while (0)
    const unsigned rgoff = wid < 7 ? (unsigned)(RING_BYTES + 1024 + wid * 4096) : (unsigned)L_END;
#define GLA_REQ_RG(cc, lane_) do { const long t0_ = tokb + (long)(cc) * GLA_CHUNK; \
        _Pragma("unroll") for (int tb_ = 0; tb_ < 4; ++tb_) glds16(proj + (t0_ + 16 * tb_ + ((lane_) >> 2)) * GLA_NP + 2048 + h * 256 + 32 * wid + 8 * ((lane_) & 3), (unsigned)__builtin_amdgcn_readfirstlane(lds0 + rgoff + tb_ * 1024)); } while (0)
    { int lane0 = threadIdx.x & 63; asm volatile("" : "+v"(lane0)); GLA_REQ_QKG(0, lane0); GLA_REQ_RG(0, lane0); GLA_REQ_V(0, lane0); }
    for (int c = 0; c <= NCH; ++c) {
        int lane = threadIdx.x & 63; asm volatile("" : "+v"(lane));
        const int r32 = lane & 31, hi = lane >> 5;
        asm volatile("s_waitcnt vmcnt(8) lgkmcnt(0)\n\ts_barrier" ::: "memory");
        if (GLA_HANDOFF && c >= 5 && ((c - 5) & 3) == 0 && threadIdx.x == 0) (void)__hip_atomic_fetch_add(rdy + 64 * ((c - 5) >> 2), 1u, RLX_AGENT);
        if (c > 0) {
            const long tok0 = tokb + (long)(c - 1) * GLA_CHUNK;
            const LAS float* ssb = (const LAS float*)(lds + L_SS);
            float t0 = 0.f, t1 = 0.f;
#pragma unroll
            for (int hb = 0; hb < 2; ++hb) { float p0[8], p1[8];
#pragma unroll
                for (int i = 0; i < 8; ++i) { p0[i] = ssb[(8 * hb + i) * 64 + r32]; p1[i] = ssb[(8 * hb + i) * 64 + 32 + r32]; }
                asm volatile("" ::: "memory");
                t0 += ((p0[0] + p0[1]) + (p0[2] + p0[3])) + ((p0[4] + p0[5]) + (p0[6] + p0[7])); t1 += ((p1[0] + p1[1]) + (p1[2] + p1[3])) + ((p1[4] + p1[5]) + (p1[6] + p1[7])); }
            const float rs0 = __builtin_amdgcn_rsqf(t0 * (1.0f / 256.0f) + EPS), rs1 = __builtin_amdgcn_rsqf(t1 * (1.0f / 256.0f) + EPS);
#pragma unroll
            for (int g = 0; g < 4; ++g) { const int v0 = 32 * wid + 8 * g + 4 * hi;
#pragma unroll
                for (int tt = 0; tt < 2; ++tt) { const long tok = tok0 + 32 * tt + r32; const float rs = tt ? rs1 : rs0;
                    const f32x4 y = (tt ? (f32x4){OT1[4 * g], OT1[4 * g + 1], OT1[4 * g + 2], OT1[4 * g + 3]} : (f32x4){OT0[4 * g], OT0[4 * g + 1], OT0[4 * g + 2], OT0[4 * g + 3]}) * rs;
                    u32x2 w; w.x = cvtpk(y[0], y[1]); w.y = cvtpk(y[2], y[3]);
                    if (GLA_HANDOFF) __hip_atomic_store((gu64*)(og + tok * DM + h * 256 + v0), (unsigned long long)w.x | ((unsigned long long)w.y << 32), RLX_AGENT);
                    else *(u32x2*)(og + tok * DM + h * 256 + v0) = w; } }
        }
        if (c == NCH) break;
        const long tok0 = tokb + (long)c * GLA_CHUNK;
        {
            const int l15 = lane & 15, quad = lane >> 4, kcol = 16 * wid + l15, pk_ = permk(kcol);
            const LAS bf16* qrp = (const LAS bf16*)(lds + L_QR + (4 * quad) * 256 + kcol * 2); const LAS bf16* krp = (const LAS bf16*)(lds + L_KR + (4 * quad) * 256 + kcol * 2);
            unsigned qraw[16], kraw[16];
#pragma unroll
            for (int i = 0; i < 4; ++i)
#pragma unroll
                for (int r = 0; r < 4; ++r) { qraw[4 * i + r] = (unsigned)qrp[(16 * i + r) * 128]; kraw[4 * i + r] = (unsigned)krp[(16 * i + r) * 128]; }
            asm volatile("" ::: "memory");
#define MFMA16(a, b, c) __builtin_amdgcn_mfma_f32_16x16x32_bf16((a), (b), (c), 0, 0, 0)
            f32x4 la[4];
#pragma unroll
            for (int i = 0; i < 4; ++i) { const bf16x8 ga = *(LAS const bf16x8*)(lds + L_GLR + (16 * i + l15) * 32 + (quad & 1) * 16);
                la[i] = MFMA16(ga, w2f, ((f32x4){bgv, bgv, bgv, bgv})); }
#pragma unroll
            for (int i = 0; i < 4; ++i) {
                f32x4 a;
#pragma unroll
                for (int e = 0; e < 4; ++e) a[e] = __builtin_amdgcn_fmed3f(la[i][e], -80.f, 80.f) * (-LOG2E);
#pragma unroll
                for (int e = 0; e < 4; ++e) a[e] = __builtin_amdgcn_exp2f(a[e]);
                a = a + 1.0f;
#pragma unroll
                for (int e = 0; e < 4; ++e) a[e] = __builtin_amdgcn_logf(a[e]);
                la[i] = a * (-1.0f / 16.0f); }
            bf16x8 lab[2], aev, aod, aon;
#pragma unroll
            for (int p_ = 0; p_ < 2; ++p_) { v4u o; o.x = cvtpk(la[2 * p_][0], la[2 * p_][1]); o.y = cvtpk(la[2 * p_][2], la[2 * p_][3]); o.z = cvtpk(la[2 * p_ + 1][0], la[2 * p_ + 1][1]); o.w = cvtpk(la[2 * p_ + 1][2], la[2 * p_ + 1][3]);
                lab[p_] = __builtin_bit_cast(bf16x8, o); }
            { const int t4 = 4 * quad; const unsigned c01 = (t4 <= l15 ? 0x3f80u : 0u) | (t4 + 1 <= l15 ? 0x3f800000u : 0u), c23 = (t4 + 2 <= l15 ? 0x3f80u : 0u) | (t4 + 3 <= l15 ? 0x3f800000u : 0u);
              v4u o; o.x = c01; o.y = c23; o.z = 0u; o.w = 0u; aev = __builtin_bit_cast(bf16x8, o);
              o.x = 0x3f803f80u; o.y = 0x3f803f80u; o.z = c01; o.w = c23; aod = __builtin_bit_cast(bf16x8, o);
              o.z = 0x3f803f80u; o.w = 0x3f803f80u; aon = __builtin_bit_cast(bf16x8, o); }
            const f32x4 zero4 = {0.f, 0.f, 0.f, 0.f};
            f32x4 BC[4];
            BC[0] = MFMA16(aev, lab[0], zero4); BC[1] = MFMA16(aod, lab[0], zero4);
            const f32x4 T01 = MFMA16(aon, lab[0], zero4);
            BC[2] = MFMA16(aev, lab[1], T01); BC[3] = MFMA16(aod, lab[1], T01);
            const f32x4 TT = MFMA16(aon, lab[1], T01);
#undef MFMA16
            const float blast = TT[0], eblast = __builtin_amdgcn_exp2f(blast);
            LAS bf16* qip = (LAS bf16*)(lds + L_QI + (4 * quad) * PQ + pk_ * 2); LAS bf16* kip = (LAS bf16*)(lds + L_KI + (4 * quad) * PQ + pk_ * 2);
            LAS u32x2* ktp_w = (LAS u32x2*)(lds + L_KT + kcol * PT + 16 * (quad & 1) + 8 * (quad >> 1));
#pragma unroll
            for (int i = 0; i < 4; ++i) {
                f32x4 eb, ei, qv4, kv4;
#pragma unroll
                for (int e = 0; e < 4; ++e) { qv4[e] = __uint_as_float(qraw[4 * i + e] << 16); kv4[e] = __uint_as_float(kraw[4 * i + e] << 16); }
#pragma unroll
                for (int e = 0; e < 4; ++e) eb[e] = __builtin_amdgcn_exp2f(BC[i][e]);
#pragma unroll
                for (int e = 0; e < 4; ++e) ei[e] = __builtin_amdgcn_rcpf(eb[e]);
                const f32x4 qt = qv4 * eb * qscale, kt4 = kv4 * ei, kh = kt4 * eblast;
                const unsigned q01 = cvtpk(qt[0], qt[1]), q23 = cvtpk(qt[2], qt[3]), k01 = cvtpk(kt4[0], kt4[1]), k23 = cvtpk(kt4[2], kt4[3]);
                qip[(16 * i + 0) * (PQ / 2)] = (bf16)(q01 & 0xffffu); qip[(16 * i + 1) * (PQ / 2)] = (bf16)(q01 >> 16); qip[(16 * i + 2) * (PQ / 2)] = (bf16)(q23 & 0xffffu); qip[(16 * i + 3) * (PQ / 2)] = (bf16)(q23 >> 16);
                kip[(16 * i + 0) * (PQ / 2)] = (bf16)(k01 & 0xffffu); kip[(16 * i + 1) * (PQ / 2)] = (bf16)(k01 >> 16); kip[(16 * i + 2) * (PQ / 2)] = (bf16)(k23 & 0xffffu); kip[(16 * i + 3) * (PQ / 2)] = (bf16)(k23 >> 16);
                ktp_w[4 * i] = (u32x2){cvtpk(kh[0], kh[1]), cvtpk(kh[2], kh[3])}; }
            if (quad == 0) ((LAS float*)(lds + L_DEC))[kcol] = eblast;
        }
        if (c == 0) asm volatile("s_waitcnt vmcnt(0) lgkmcnt(0)\n\ts_barrier" ::: "memory");
        else asm volatile("s_waitcnt vmcnt(8) lgkmcnt(0)\n\ts_barrier" ::: "memory");
        if (c + 1 < NCH) GLA_REQ_QKG(c + 1, lane);
        f32x16 X00, X01, X11; const f32x16 zero16m = {0.f, 0.f, 0.f, 0.f, 0.f, 0.f, 0.f, 0.f, 0.f, 0.f, 0.f, 0.f, 0.f, 0.f, 0.f, 0.f};
        lds_cptr qi = (lds_cptr)lds + L_QI + r32 * PQ + hi * 16, ki = (lds_cptr)lds + L_KI + r32 * PQ + hi * 16;
        bf16x8 xa0[2], xa1[2], xb0[2], xb1[2];
#define GL_XLD(ks_, s_) do { xa0[s_] = *(LAS const bf16x8*)(ki + (ks_) * 32); xa1[s_] = *(LAS const bf16x8*)(ki + 32 * PQ + (ks_) * 32); \
                             xb0[s_] = *(LAS const bf16x8*)(qi + (ks_) * 32); xb1[s_] = *(LAS const bf16x8*)(qi + 32 * PQ + (ks_) * 32); } while (0)
        f32x4 sg[2][4]; u32x2 rrv[2][4];
        GL_XLD(0, 0);
#pragma unroll
        for (int g = 0; g < 4; ++g) {
#pragma unroll
            for (int tt = 0; tt < 2; ++tt) rrv[tt][g] = *(LAS const u32x2*)(lds + rgoff + (32 * tt + r32) * 64 + (8 * g + 4 * hi) * 2); }
#pragma unroll
        for (int ks = 0; ks < 8; ++ks) {
            if (ks < 7) GL_XLD(ks + 1, (ks + 1) & 1);
            __builtin_amdgcn_sched_barrier(0);
            if (ks == 0) { X00 = MFMA32(xa0[0], xb0[0], zero16m); X01 = MFMA32(xa0[0], xb1[0], zero16m); X11 = MFMA32(xa1[0], xb1[0], zero16m); }
            else { X00 = MFMA32(xa0[ks & 1], xb0[ks & 1], X00); X01 = MFMA32(xa0[ks & 1], xb1[ks & 1], X01); X11 = MFMA32(xa1[ks & 1], xb1[ks & 1], X11); }
            { const int g = ks >> 1, tt = ks & 1; const u32x2 rr = rrv[tt][g];
              sg[tt][g] = (f32x4){__uint_as_float(rr.x << 16), __uint_as_float(rr.x & 0xffff0000u), __uint_as_float(rr.y << 16), __uint_as_float(rr.y & 0xffff0000u)}; }
            __builtin_amdgcn_sched_barrier(0); }
#undef GL_XLD
#pragma unroll
        for (int r = 0; r < 16; ++r) if (crow(r, hi) > r32) { X00[r] = 0.f; X11[r] = 0.f; }
        lds_cptr vw = (lds_cptr)lds + L_VI + wid * 4096 + ((lane >> 4) & 1) * 32 + (lane & 3) * 8 + ((lane & 15) >> 2) * 64;
#define GL_VA(st, sp) cat8(vtr(vw + (32 * (st) + 16 * (sp) + 4 * hi) * 64), vtr(vw + (32 * (st) + 16 * (sp) + 4 * hi + 8) * 64))
        const bf16x8 va00 = GL_VA(0, 0), va01 = GL_VA(0, 1), va10 = GL_VA(1, 0), va11 = GL_VA(1, 1);
#undef GL_VA
        asm volatile("s_waitcnt lgkmcnt(0)" ::: "memory");
        GLA_REQ_RG(c + 1 < NCH ? c + 1 : c, lane); GLA_REQ_V(c + 1 < NCH ? c + 1 : c, lane);
        OT0 = MFMA32(va00, pk8(X00, 0), zero16m); OT0 = MFMA32(va01, pk8(X00, 1), OT0);
        OT1 = MFMA32(va00, pk8(X01, 0), zero16m); OT1 = MFMA32(va01, pk8(X01, 1), OT1);
        OT1 = MFMA32(va10, pk8(X11, 0), OT1); OT1 = MFMA32(va11, pk8(X11, 1), OT1);
        f32x4 dlo[8], dhi[8];
#pragma unroll
        for (int i = 0; i < 8; ++i) dlo[i] = *(LAS const f32x4*)(lds + L_DEC + (32 * (i >> 2) + 8 * (i & 3) + 4 * hi) * 4);
        bf16x8 bq0[2], bq1[2];
        bq0[0] = *(LAS const bf16x8*)(qi); bq1[0] = *(LAS const bf16x8*)(qi + 32 * PQ);
#pragma unroll
        for (int i = 0; i < 8; ++i) {
            if (i < 7) { bq0[(i + 1) & 1] = *(LAS const bf16x8*)(qi + (i + 1) * 32); bq1[(i + 1) & 1] = *(LAS const bf16x8*)(qi + 32 * PQ + (i + 1) * 32); }
            __builtin_amdgcn_sched_barrier(0);
            const bf16x8 sa = pk8(S[i >> 1], i & 1);
            OT0 = MFMA32(sa, bq0[i & 1], OT0); OT1 = MFMA32(sa, bq1[i & 1], OT1);
            __builtin_amdgcn_sched_barrier(0); }
#pragma unroll
        for (int i = 0; i < 8; ++i) dhi[i] = *(LAS const f32x4*)(lds + L_DEC + (32 * (2 + (i >> 2)) + 8 * (i & 3) + 4 * hi) * 4);
        __builtin_amdgcn_sched_barrier(0);
#pragma unroll
        for (int i = 0; i < 8; ++i) { const int kt = i >> 2, g = i & 3; S[kt][4 * g] *= dlo[i][0]; S[kt][4 * g + 1] *= dlo[i][1]; S[kt][4 * g + 2] *= dlo[i][2]; S[kt][4 * g + 3] *= dlo[i][3]; }
        lds_cptr ktp = (lds_cptr)lds + L_KT + r32 * PT + hi * 16;
        bf16x8 ak[2][4];
#pragma unroll
        for (int kt = 0; kt < 4; ++kt) ak[0][kt] = *(LAS const bf16x8*)(ktp + kt * 32 * PT);
        __builtin_amdgcn_sched_barrier(0);
#pragma unroll
        for (int i = 0; i < 8; ++i) { const int kt = 2 + (i >> 2), g = i & 3; S[kt][4 * g] *= dhi[i][0]; S[kt][4 * g + 1] *= dhi[i][1]; S[kt][4 * g + 2] *= dhi[i][2]; S[kt][4 * g + 3] *= dhi[i][3]; }
#pragma unroll
        for (int ts = 0; ts < 4; ++ts) { const bf16x8 vb = ts == 0 ? va00 : ts == 1 ? va01 : ts == 2 ? va10 : va11;
            if (ts < 3) {
#pragma unroll
                for (int kt = 0; kt < 4; ++kt) ak[(ts + 1) & 1][kt] = *(LAS const bf16x8*)(ktp + kt * 32 * PT + (ts + 1) * 32); }
            __builtin_amdgcn_sched_barrier(0);
#pragma unroll
            for (int kt = 0; kt < 4; ++kt) S[kt] = MFMA32(ak[ts & 1][kt], vb, S[kt]);
            __builtin_amdgcn_sched_barrier(0); }
        { float ss0 = 0.f, ss1 = 0.f;
#pragma unroll
          for (int r = 0; r < 16; ++r) { ss0 += OT0[r] * OT0[r]; ss1 += OT1[r] * OT1[r]; }
          LAS float* ssb = (LAS float*)(lds + L_SS);
          ssb[(wid * 2 + hi) * 64 + r32] = ss0; ssb[(wid * 2 + hi) * 64 + 32 + r32] = ss1; }
#pragma unroll
        for (int g = 0; g < 4; ++g)
#pragma unroll
            for (int e = 0; e < 4; ++e) { OT0[4 * g + e] *= sg[0][g][e]; OT1[4 * g + e] *= sg[1][g][e]; }
    }
    asm volatile("s_waitcnt vmcnt(0) lgkmcnt(0)\n\ts_barrier" ::: "memory");
    if (GLA_HANDOFF && threadIdx.x == 0) (void)__hip_atomic_fetch_add(rdy + 64 * 7, 1u, RLX_AGENT);
#undef GLA_REQ_QKG
#undef GLA_REQ_V
#undef GLA_REQ_RG
}
}

#ifndef SB_EARLY
#define SB_EARLY 1
#endif
struct Args { const float* in[14]; float* out; unsigned char* ws; int ph_lo, ph_hi; };
constexpr int N_PHASES = 21;
typedef __attribute__((address_space(4))) const Args* kargs_t;
__device__ __forceinline__ kargs_t kargs() { kargs_t p = (kargs_t)__builtin_amdgcn_kernarg_segment_ptr(); asm volatile("" : "+s"(p)); return p; }
__global__ void __launch_bounds__(NWAVES * 64, 2) fwd(Args args_unused) {
    extern __shared__ __attribute__((aligned(16))) unsigned char lds_raw[];
    LAS unsigned char* lds = (LAS unsigned char*)lds_raw;
    (void)args_unused;
    { const int tid = threadIdx.x; for (int u = tid; u < (LDS_BYTES - LDSCTL_OFF) / 4; u += NWAVES * 64) ((LAS unsigned*)(lds + LDSCTL_OFF))[u] = 0u; }
    __syncthreads();
    const int lo = kargs()->ph_lo, hi_ = kargs()->ph_hi;
    XcdBarrier bar; bar.bar = (unsigned*)(kargs()->ws + WS_CTL) + CW_BAR; bar.x = 0; bar.st = nullptr;
    if (hi_ - lo > 1) bar = xcd_barrier_post((unsigned*)(kargs()->ws + WS_CTL) + CW_BAR, (volatile LAS unsigned*)(lds + MISC_OFF) + 8);
#ifndef PHASE_MASK
#define PHASE_MASK 0x7ff
#endif
#define IN(k) (lo <= (k) && (k) < hi_)
#define INL(n) (((PHASE_MASK >> ((n) + 1)) & 1) && IN(pb + (n)))
#define SEAM(k) do { if (IN(k) && IN((k) + 1)) xcd_barrier(bar); } while (0)
#define WSP(T, off) ((T*)(A->ws + (off)))
#define GRID_ID const int G = gridDim.x, bx = blockIdx.x

    if ((PHASE_MASK & 1) && IN(0)) { const kargs_t A = kargs(); GRID_ID;
        const int tid = threadIdx.x, lane = tid & 63, wave = __builtin_amdgcn_readfirstlane(tid >> 6), vcu = (G % 8 == 0) ? (bx % 8) * (G / 8) + bx / 8 : bx;
        Ptrs P;
        P.x = A->in[0]; P.attn_g = A->in[1]; P.ffn_g = A->in[2]; P.gla_win = A->in[3]; P.gla_w2 = A->in[4]; P.gla_b = A->in[5]; P.gla_ng = A->in[6]; P.gla_wout = A->in[7];
        P.sb_win = A->in[8]; P.sb_qg = A->in[9]; P.sb_kg = A->in[10]; P.sb_wout = A->in[11]; P.wgu = A->in[12]; P.wd = A->in[13]; P.out = A->out; P.ws = A->ws;
        p0_prologue(P, lds, vcu, G, wave, lane); }
    SEAM(0);
#pragma unroll 1
    for (int jj = 0; jj < 2; ++jj) {
        const int pb = 1 + 10 * jj;
        if (INL(0)) { const kargs_t A = kargs(); GRID_ID; constexpr int PHN = 0; (void)PHN;
            pg8::Gemm g{WSP(const bf16, WS_XB), WSP(const bf16, WS_GLA_WIN + (size_t)jj * 7 * MiB), M, GLA_NP, DM}; pg8::DynOrder S; S.init(M, GLA_NP, G, bx); S.cnt = (unsigned*)(A->ws + WS_CTL) + CW_DYN + (pb + PHN) * 1024; S.slot = (LAS int*)(lds + LDSCTL_OFF + 64);
            pg8::EpiProj<0> E{(LAS float*)(lds + pg8::RSTD_OFF), WSP(bf16, WS_PROJ), GLA_NP, WSP(const float, WS_ROWSS), A->in[6] + jj * GLA_HV  , nullptr, 1.f, GLA_IN};
            pg8::gemm_phase<pg8::EpiProj<0>, pg8::DynOrder, true, true>(lds, g, S, E);
        }
        SEAM(pb + 0);
        if (INL(1)) { const kargs_t A = kargs(); GRID_ID; constexpr int PHN = 1; (void)PHN;
            constexpr int NSEQ = BATCH * GLA_H;
            for (int sq = bx; sq < NSEQ; sq += G) glp::gla_seq(sq >> 2, sq & 3, WSP(const bf16, WS_PROJ), A->in[4] + (size_t)jj * GLA_RANK * 512, A->in[5] + jj * 512, A->in[6] + jj * GLA_HV, WSP(bf16, WS_OG),
                                                                (unsigned*)(A->ws + WS_CTL) + CW_RDY + jj * 16384 + 64 * 8 * (sq >> 2), lds);
            if (bx >= NSEQ || G <= NSEQ) { int tid_ = threadIdx.x; asm volatile("" : "+v"(tid_)); const int lane = tid_ & 63, wave = __builtin_amdgcn_readfirstlane(tid_ >> 6);
                Ptrs P; P.x = A->in[0]; P.attn_g = A->in[1]; P.ffn_g = A->in[2]; P.gla_win = A->in[3]; P.gla_w2 = A->in[4]; P.gla_b = A->in[5]; P.gla_ng = A->in[6]; P.gla_wout = A->in[7];
                P.sb_win = A->in[8]; P.sb_qg = A->in[9]; P.sb_kg = A->in[10]; P.sb_wout = A->in[11]; P.wgu = A->in[12]; P.wd = A->in[13]; P.out = A->out; P.ws = A->ws;
                const int nconv = G > NSEQ ? G - NSEQ : G, wg = G > NSEQ ? bx - NSEQ : bx;
                wt_convert(P, lds, wg * NWAVES + wave, nconv * NWAVES, wave, lane, jj + 1); }
        }
#if GLA_HANDOFF
        if (INL(2)) { const kargs_t A = kargs(); GRID_ID; constexpr int PHN = 2; (void)PHN;
            WG_BAR();
            pg8::Gemm g{WSP(const bf16, WS_OG), WSP(const bf16, WS_GLA_WOUT + (size_t)jj * 2 * MiB), M, DM, DM}; pg8::GlaOutOrder S; S.init(M, DM, G, bx); S.cnt = (unsigned*)(A->ws + WS_CTL) + CW_DYN + (pb + PHN) * 1024; S.slot = (LAS int*)(lds + LDSCTL_OFF + 64);
            S.ready = (unsigned*)(A->ws + WS_CTL) + CW_RDY + jj * 16384; S.tmo = (unsigned*)(A->ws + WS_CTL) + CW_RDY_TMO;
            pg8::EpiResid<false> E{WSP(bf16, WS_XB), nullptr, WSP(float, WS_ROWSS)};
            pg8::gemm_phase<pg8::EpiResid<false>, pg8::GlaOutOrder, true, true>(lds, g, S, E);
        }
#else
        SEAM(pb + 1);
        if (INL(2)) { const kargs_t A = kargs(); GRID_ID; constexpr int PHN = 2; (void)PHN;
            pg8::Gemm g{WSP(const bf16, WS_OG), WSP(const bf16, WS_GLA_WOUT + (size_t)jj * 2 * MiB), M, DM, DM}; pg8::DynOrder S; S.init(M, DM, G, bx); S.cnt = (unsigned*)(A->ws + WS_CTL) + CW_DYN + (pb + PHN) * 1024; S.slot = (LAS int*)(lds + LDSCTL_OFF + 64);
            pg8::EpiResid<false> E{WSP(bf16, WS_XB), nullptr, WSP(float, WS_ROWSS)};
            pg8::gemm_phase<pg8::EpiResid<false>, pg8::DynOrder, true, true>(lds, g, S, E);
        }
#endif
        SEAM(pb + 2);
        if (INL(3)) { const kargs_t A = kargs(); GRID_ID; constexpr int PHN = 3; (void)PHN;
            pg8::Gemm g{WSP(const bf16, WS_XB), WSP(const bf16, WS_WGU + (size_t)(2 * jj) * 11 * MiB), M, 2 * DFF, DM}; pg8::DynOrder S; S.init(M, 2 * DFF, G, bx); S.cnt = (unsigned*)(A->ws + WS_CTL) + CW_DYN + (pb + PHN) * 1024; S.slot = (LAS int*)(lds + LDSCTL_OFF + 64);
            pg8::EpiSwiGLU E{WSP(bf16, WS_PROJ), DFF, WSP(const float, WS_ROWSS), (LAS float*)(lds + pg8::RSTD_OFF)};
            pg8::gemm_phase<pg8::EpiSwiGLU, pg8::DynOrder, true, true>(lds, g, S, E);
        }
        SEAM(pb + 3);
        if (INL(4)) { const kargs_t A = kargs(); GRID_ID; constexpr int PHN = 4; (void)PHN;
            pg8::Gemm g{WSP(const bf16, WS_PROJ), WSP(const bf16, WS_WD + (size_t)(2 * jj) * 6 * MiB), M, DM, DFF}; pg8::DynOrder S; S.init(M, DM, G, bx, 1); S.cnt = (unsigned*)(A->ws + WS_CTL) + CW_DYN + (pb + PHN) * 1024; S.slot = (LAS int*)(lds + LDSCTL_OFF + 64);
            pg8::EpiResid<false> E{WSP(bf16, WS_XB), nullptr, WSP(float, WS_ROWSS)};
            pg8::gemm_phase<pg8::EpiResid<false>, pg8::DynOrder, true, true>(lds, g, S, E);
        }
        SEAM(pb + 4);
        if (INL(5)) { const kargs_t A = kargs(); GRID_ID; constexpr int PHN = 5; (void)PHN;
            pg8::Gemm g{WSP(const bf16, WS_XB), WSP(const bf16, WS_SB_WIN + (size_t)jj * 6 * MiB), M, SB_N, DM}; pg8::DynOrder S; S.init(M, SB_N, G, bx); S.cnt = (unsigned*)(A->ws + WS_CTL) + CW_DYN + (pb + PHN) * 1024; S.slot = (LAS int*)(lds + LDSCTL_OFF + 64);
            pg8::EpiProj<1> E{(LAS float*)(lds + pg8::RSTD_OFF), WSP(bf16, WS_PROJ), SB_N, WSP(const float, WS_ROWSS), A->in[9] + jj * 64, A->in[10] + jj * 64, 0.125f * LOG2E, SB_N};
            pg8::gemm_phase<pg8::EpiProj<1>, pg8::DynOrder, true, true>(lds, g, S, E);
        }
        SEAM(pb + 5);
        if (INL(6)) { const kargs_t A = kargs(); GRID_ID; constexpr int PHN = 6; (void)PHN;
            for (int p = bx; p < M / 256; p += G) { const int b = p >> 3, qb = p & 7;
#pragma unroll 1
                for (int hh = 0; hh < 16; ++hh) sbp::sb_unit<SB_EARLY != 0>(b, hh, qb, WSP(const bf16, WS_PROJ), WSP(bf16, WS_OG), lds);
                pg8::Gemm g{WSP(const bf16, WS_OG), WSP(const bf16, WS_SB_WOUT + (size_t)jj * 2 * MiB), M, DM, DM}; pg8::PanelOrder S; S.init(M, DM, G, bx); S.p = p;
                pg8::EpiResid<false> E{WSP(bf16, WS_XB), nullptr, WSP(float, WS_ROWSS)};
                pg8::gemm_phase<pg8::EpiResid<false>, pg8::PanelOrder, true, true>(lds, g, S, E); }
        }
        do { if (IN(pb + 6) && IN(pb + 8)) xcd_barrier(bar); } while (0);
        if (INL(8)) { const kargs_t A = kargs(); GRID_ID; constexpr int PHN = 8; (void)PHN;
            pg8::Gemm g{WSP(const bf16, WS_XB), WSP(const bf16, WS_WGU + (size_t)(2 * jj + 1) * 11 * MiB), M, 2 * DFF, DM}; pg8::DynOrder S; S.init(M, 2 * DFF, G, bx); S.cnt = (unsigned*)(A->ws + WS_CTL) + CW_DYN + (pb + PHN) * 1024; S.slot = (LAS int*)(lds + LDSCTL_OFF + 64);
            pg8::EpiSwiGLU E{WSP(bf16, WS_PROJ), DFF, WSP(const float, WS_ROWSS), (LAS float*)(lds + pg8::RSTD_OFF)};
            pg8::gemm_phase<pg8::EpiSwiGLU, pg8::DynOrder, true, true>(lds, g, S, E);
        }
        SEAM(pb + 8);
        if (INL(9)) { const kargs_t A = kargs(); GRID_ID; constexpr int PHN = 9; (void)PHN;
            pg8::Gemm g{WSP(const bf16, WS_PROJ), WSP(const bf16, WS_WD + (size_t)(2 * jj + 1) * 6 * MiB), M, DM, DFF}; pg8::DynOrder S; S.init(M, DM, G, bx, 1); S.cnt = (unsigned*)(A->ws + WS_CTL) + CW_DYN + (pb + PHN) * 1024; S.slot = (LAS int*)(lds + LDSCTL_OFF + 64);
            if (jj == 0) { pg8::EpiResid<false> E{WSP(bf16, WS_XB), nullptr, WSP(float, WS_ROWSS)}; pg8::gemm_phase<pg8::EpiResid<false>, pg8::DynOrder, true, true>(lds, g, S, E); }
            else { pg8::EpiResid<true> E{WSP(bf16, WS_XB), A->out, nullptr}; pg8::gemm_phase<pg8::EpiResid<true>, pg8::DynOrder, true, true>(lds, g, S, E); }
        }
        SEAM(pb + 9);
    }
#undef IN
#undef INL
#undef SEAM
#undef WSP
#undef GRID_ID
}

#ifndef MK_PER_PHASE
#define MK_PER_PHASE 0
#endif
extern "C" void kernel_launch(void* const* d_in, const int* in_sizes, int n_in, void* d_out, int out_size, void* d_ws, size_t ws_size, hipStream_t stream) {
    static int grid = 0;
    if (grid == 0) {
        if (n_in != 14 || in_sizes[0] != M * DM || out_size != M * DM || ws_size < WS_END) { fprintf(stderr, "kernel_launch: unexpected shapes (n_in %d, in0 %d, out %d, ws %zu)\n", n_in, n_in > 0 ? in_sizes[0] : -1, out_size, ws_size); grid = -1; return; }
        int dev = 0, cus = 0, per_cu = 0;
        if (hipGetDevice(&dev) != hipSuccess || hipDeviceGetAttribute(&cus, hipDeviceAttributeMultiprocessorCount, dev) != hipSuccess) { grid = -1; return; }
        if (hipFuncSetAttribute((const void*)fwd, hipFuncAttributeMaxDynamicSharedMemorySize, LDS_BYTES) != hipSuccess) { fprintf(stderr, "kernel_launch: hipFuncSetAttribute failed\n"); grid = -1; return; }
        if (hipOccupancyMaxActiveBlocksPerMultiprocessor(&per_cu, (const void*)fwd, NWAVES * 64, LDS_BYTES) != hipSuccess || per_cu < 1) { fprintf(stderr, "kernel_launch: occupancy query says %d blocks per CU\n", per_cu); }
        (void)hipGetLastError();
        grid = cus;
    }
    if (grid < 0) return;
    (void)hipMemsetAsync((char*)d_ws + WS_CTL, 0, CTL_ZERO_BYTES, stream);
    Args a{};
    for (int i = 0; i < 14; ++i) a.in[i] = (const float*)d_in[i];
    a.out = (float*)d_out; a.ws = (unsigned char*)d_ws;
#if MK_PER_PHASE
    for (int p = 0; p < N_PHASES; ++p) { a.ph_lo = p; a.ph_hi = p + 1; hipLaunchKernelGGL(fwd, dim3(grid), dim3(NWAVES * 64), LDS_BYTES, stream, a); }
#else
    a.ph_lo = 0; a.ph_hi = N_PHASES;
    hipLaunchKernelGGL(fwd, dim3(grid), dim3(NWAVES * 64), LDS_BYTES, stream, a);
#endif
}
```
